# Optimizing an MI355X kernel written in HIP

```python
import jax, jax.numpy as jnp
from jax import lax
import numpy as np

D_MODEL = 1024
BATCH = 8
SEQ = 2048
DEPTH = 1

D_MIX = D_MODEL
D_POOL = D_MIX // 2
POOL_WINDOWS = (2, 4, 8, 16)
N_POOL_GROUPS = len(POOL_WINDOWS)
POOL_GROUP = D_POOL // N_POOL_GROUPS
D_ATTN = D_MIX - D_POOL
HEAD_DIM = 64
N_HEADS = D_ATTN // HEAD_DIM
DILATED_PATTERNS = ((128, 1), (512, 4), (2048, 16))
Q_BLOCK = 128
N_EXPERTS = 32
TOP_K = 4
D_EXPERT = D_MODEL
SWIGLU_LIMIT = 7.0
SWIGLU_ALPHA = 1.702
EPS = 1e-5
NEG_INF = -1e30

kernel_name = 'hybrid_pool_dilated_attn_moe'


def rmsnorm(x, g):
    xf = x.astype(jnp.float32)
    y = xf * lax.rsqrt(jnp.mean(xf * xf, axis=-1, keepdims=True) + EPS)
    return (y * g.astype(jnp.float32)).astype(x.dtype)


def causal_multiscale_pool(u, w_pool, pool_scale):
    B, S, _ = u.shape
    uf = u.astype(jnp.float32)
    cs = jnp.concatenate([jnp.zeros((B, 1, D_POOL), jnp.float32), jnp.cumsum(uf, axis=1)], axis=1)
    t = jnp.arange(S)
    groups = []
    for gi, w in enumerate(POOL_WINDOWS):
        lo, hi = gi * POOL_GROUP, (gi + 1) * POOL_GROUP
        start = jnp.maximum(t + 1 - w, 0)
        csg = cs[:, :, lo:hi]
        win_sum = csg[:, 1:] - csg[:, start]
        count = (t + 1 - start).astype(jnp.float32)[None, :, None]
        groups.append(win_sum / count - uf[:, :, lo:hi])
    pooled = jnp.stack(groups, axis=2)
    y = jnp.einsum('bsgc,gcd->bsgd', pooled, w_pool.astype(jnp.float32)).reshape(B, S, D_POOL)
    return (y * pool_scale.astype(jnp.float32)).astype(u.dtype)


def dilated_branch(q, k, v, window, dilation):
    B, H, S, hd = q.shape
    n_back = window // dilation
    Lc = S // dilation
    nb = -(-Lc // Q_BLOCK)
    Lp = nb * Q_BLOCK

    def compress(a):
        a = a.reshape(B, H, Lc, dilation, hd).transpose(0, 1, 3, 2, 4)
        return jnp.pad(a, ((0, 0), (0, 0), (0, 0), (0, Lp - Lc), (0, 0)))

    def slabs(a):
        a = jnp.pad(a, ((0, 0), (0, 0), (0, 0), (Q_BLOCK, 0), (0, 0)))
        a = a.reshape(B, H, dilation, nb + 1, Q_BLOCK, hd)
        return jnp.concatenate([a[:, :, :, :-1], a[:, :, :, 1:]], axis=4)

    qb = compress(q).reshape(B, H, dilation, nb, Q_BLOCK, hd)
    ks = slabs(compress(k))
    vs = slabs(compress(v))
    s = jnp.einsum('bhrnqe,bhrnke->bhrnqk', qb, ks, preferred_element_type=jnp.float32)
    qi = jnp.arange(Q_BLOCK)[:, None]
    kj = jnp.arange(2 * Q_BLOCK)[None, :]
    diff = qi + Q_BLOCK - kj
    band = (diff >= 0) & (diff <= n_back)
    key_pos = (jnp.arange(nb)[:, None, None] - 1) * Q_BLOCK + kj[None]
    mask = band[None] & (key_pos >= 0)
    s = jnp.where(mask, s, NEG_INF)
    m = jnp.max(s, axis=-1, keepdims=True)
    p = jnp.exp(s - m)
    l = jnp.sum(p, axis=-1)
    o = jnp.einsum('bhrnqk,bhrnke->bhrnqe', p, vs.astype(jnp.float32)) / l[..., None]

    def uncompress(a, tail):
        a = a.reshape((B, H, dilation, Lp) + tail)[:, :, :, :Lc]
        a = jnp.moveaxis(a, 2, 3)
        return a.reshape((B, H, S) + tail)

    return uncompress(o, (hd,)), uncompress(m[..., 0], ()), uncompress(l, ())


def dilated_attention(q, k, v):
    outs = [dilated_branch(q, k, v, w, d) for (w, d) in DILATED_PATTERNS]
    m_all = outs[0][1]
    for _, m_i, _ in outs[1:]:
        m_all = jnp.maximum(m_all, m_i)
    wts = [l_i * jnp.exp(m_i - m_all) for (_, m_i, l_i) in outs]
    total = wts[0] + wts[1] + wts[2]
    o = (wts[0][..., None] * outs[0][0] + wts[1][..., None] * outs[1][0]
         + wts[2][..., None] * outs[2][0]) / total[..., None]
    return o


def moe_ffn(h, w_router, b_router, w_gu, b_gu, w_down, b_down):
    B, S, D = h.shape
    t = h.reshape(B * S, D)
    logits = (jnp.dot(t, w_router, preferred_element_type=jnp.float32) + b_router.astype(jnp.float32))
    top_vals, top_idx = lax.top_k(logits, TOP_K)
    gates = jax.nn.softmax(top_vals, axis=-1)
    combine = jnp.sum(jax.nn.one_hot(top_idx, N_EXPERTS, dtype=jnp.float32) * gates[..., None], axis=1)
    out = jnp.zeros((B * S, D), jnp.float32)
    for e in range(N_EXPERTS):
        gu = jnp.dot(t, w_gu[e], preferred_element_type=jnp.float32) + b_gu[e].astype(jnp.float32)
        gate = jnp.minimum(gu[:, :D_EXPERT], SWIGLU_LIMIT)
        lin = jnp.clip(gu[:, D_EXPERT:], -SWIGLU_LIMIT, SWIGLU_LIMIT)
        act = gate * jax.nn.sigmoid(SWIGLU_ALPHA * gate) * (lin + 1.0)
        y = jnp.dot(act.astype(h.dtype), w_down[e], preferred_element_type=jnp.float32) + b_down[e].astype(jnp.float32)
        out = out + combine[:, e:e + 1] * y
    return out.reshape(B, S, D).astype(h.dtype)


def setup_inputs(seed: int = 0) -> dict:
    key = jax.random.key(seed)
    ks = jax.random.split(key, 14)
    f32 = jnp.float32
    d_in = D_POOL + 3 * D_ATTN
    nrm = lambda k, shape, scale: jax.random.normal(k, shape, f32) * scale
    return {
        'x': nrm(ks[0], (BATCH, SEQ, D_MODEL), 1.0),
        'g_mix': 1.0 + nrm(ks[1], (DEPTH, D_MODEL), 0.02),
        'w_in': nrm(ks[2], (DEPTH, D_MODEL, d_in), D_MODEL ** -0.5),
        'w_pool': nrm(ks[3], (DEPTH, N_POOL_GROUPS, POOL_GROUP, POOL_GROUP), POOL_GROUP ** -0.5),
        'pool_scale': 1.0 + nrm(ks[4], (DEPTH, D_POOL), 0.02),
        'w_out': nrm(ks[5], (DEPTH, D_MIX, D_MODEL), D_MIX ** -0.5),
        'g_ffn': 1.0 + nrm(ks[6], (DEPTH, D_MODEL), 0.02),
        'w_router': nrm(ks[7], (DEPTH, D_MODEL, N_EXPERTS), D_MODEL ** -0.5),
        'b_router': nrm(ks[8], (DEPTH, N_EXPERTS), 0.01),
        'w_gu': nrm(ks[9], (DEPTH, N_EXPERTS, D_MODEL, 2 * D_EXPERT), D_MODEL ** -0.5),
        'b_gu': nrm(ks[10], (DEPTH, N_EXPERTS, 2 * D_EXPERT), 0.01),
        'w_down': nrm(ks[11], (DEPTH, N_EXPERTS, D_EXPERT, D_MODEL), D_EXPERT ** -0.5),
        'b_down': nrm(ks[12], (DEPTH, N_EXPERTS, D_MODEL), 0.01),
        'g_final': 1.0 + nrm(ks[13], (D_MODEL,), 0.02),
    }


def reference(x, g_mix, w_in, w_pool, pool_scale, w_out, g_ffn, w_router, b_router,
              w_gu, b_gu, w_down, b_down, g_final):
    B, S, _ = x.shape

    def heads(a):
        return a.reshape(B, S, N_HEADS, HEAD_DIM).transpose(0, 2, 1, 3)

    for layer in range(DEPTH):
        h = rmsnorm(x, g_mix[layer])
        proj = jnp.dot(h, w_in[layer], preferred_element_type=jnp.float32).astype(x.dtype)
        u = proj[..., :D_POOL]
        q = heads(proj[..., D_POOL:D_POOL + D_ATTN]) * (HEAD_DIM ** -0.5)
        k = heads(proj[..., D_POOL + D_ATTN:D_POOL + 2 * D_ATTN])
        v = heads(proj[..., D_POOL + 2 * D_ATTN:])
        y_pool = causal_multiscale_pool(u, w_pool[layer], pool_scale[layer])
        y_attn = dilated_attention(q, k, v).transpose(0, 2, 1, 3).reshape(B, S, D_ATTN).astype(x.dtype)
        mixed = jnp.concatenate([y_pool, y_attn], axis=-1)
        x = x + jnp.dot(mixed, w_out[layer], preferred_element_type=jnp.float32).astype(x.dtype)
        h2 = rmsnorm(x, g_ffn[layer])
        x = x + moe_ffn(h2, w_router[layer], b_router[layer], w_gu[layer], b_gu[layer],
                        w_down[layer], b_down[layer])
    return rmsnorm(x, g_final)
```

```cpp
#include <hip/hip_runtime.h>
#include <cstdio>
#include <cstdint>
#ifndef PROBE_DUP
#define PROBE_DUP 0
#endif
#define DUPN(k) (((PROBE_DUP >> (k)) & 1) ? 2 : 1)

#define GAS __attribute__((address_space(1)))
#define LAS __attribute__((address_space(3)))
typedef unsigned short bf16_t;
typedef short bf16x8 __attribute__((ext_vector_type(8)));
typedef float f32x4 __attribute__((ext_vector_type(4)));
typedef float f32x2 __attribute__((ext_vector_type(2)));
typedef unsigned u32x4 __attribute__((ext_vector_type(4)));
typedef unsigned u32x2 __attribute__((ext_vector_type(2)));
typedef __bf16 bf16x2_t __attribute__((ext_vector_type(2)));
typedef short v4i16_t __attribute__((ext_vector_type(4)));

__device__ __forceinline__ unsigned pkbf(float lo, float hi) { f32x2 v = {lo, hi}; bf16x2_t b = __builtin_convertvector(v, bf16x2_t); return __builtin_bit_cast(unsigned, b); }
__device__ __forceinline__ float bflo(unsigned w) { return __uint_as_float(w << 16); }
__device__ __forceinline__ float bfhi(unsigned w) { return __uint_as_float(w & 0xffff0000u); }
__device__ __forceinline__ int rfl(int v) { return __builtin_amdgcn_readfirstlane(v); }

constexpr int T = 16384, D = 1024, SEQ = 2048, NH = 8, HD = 64, DP = 512, DA = 512, NE = 32, TOPK = 4, DE = 1024;
constexpr float EPS = 1e-5f;
constexpr int MAXROWS = 73728;
constexpr float QSCALE = 0.125f * 1.4426950408889634f;

constexpr float W_SCALE = 64.0f, XS_SCALE = 16.0f, ACT_SCALE = 4.0f, Y_SCALE = 16.0f;
__device__ __forceinline__ float clamp448(float v) { return fminf(fmaxf(v, -448.0f), 448.0f); }
__device__ __forceinline__ unsigned pk4f8(float a, float b, float c, float d) {
    int w = __builtin_amdgcn_cvt_pk_fp8_f32(clamp448(a), clamp448(b), 0, false);
    w = __builtin_amdgcn_cvt_pk_fp8_f32(clamp448(c), clamp448(d), w, true);
    return (unsigned)w;
}
typedef int v8i32 __attribute__((ext_vector_type(8)));
namespace pg8 {
constexpr int BM = 256, BK = 64, HALF = 128, HTB = HALF * BK * 2, STAGE_BYTES = 8 * HTB, NXCD = 8, WGM = 8;
__host__ __device__ __forceinline__ int lds_byte(int r, int c) { const int st = (r >> 4) * 2 + (c >> 5), rr = r & 15, cc = c & 31, ob = rr * 64 + cc * 2; return st * 1024 + (ob ^ (((ob >> 9) & 1) << 5)); }
__host__ __device__ __forceinline__ void stage_rc(int b, int& R, int& C) { const int st = b / 1024, sb = b % 1024, swz = sb ^ (((sb >> 9) & 1) << 5); R = (st >> 1) * 16 + swz / 64; C = (st & 1) * 32 + (swz % 64) / 2; }
__host__ __device__ __forceinline__ int perm32(int rho) { const int n = rho >> 4, i = rho & 15; return 8 * (i >> 2) + 4 * n + (i & 3); }

struct Unit { int pm, pn, e, ui; };
struct Gemm { const bf16_t* A; const bf16_t* Bt; int K; };

struct StaticOrder {
    int nM, nN, nwg, G, c, rb;
    __device__ void init(int M, int N, int rb_, int G_, int c_) { nM = M / BM; nN = N / BM; nwg = nM * nN; G = G_; c = c_; rb = rb_; }
    __device__ __forceinline__ bool next(int i, Unit& u) const {
        const long L = (long)i * G + c; if (L >= nwg) return false;
        int wgid = (int)L; { const int q = nwg / NXCD, r = nwg % NXCD, xcd = wgid % NXCD, off = wgid / NXCD; wgid = (xcd < r ? xcd * (q + 1) : r * (q + 1) + (xcd - r) * q) + off; }
        const int nig = WGM * nN, gid = wgid / nig, fm = gid * WGM, gsz = (nM - fm) < WGM ? (nM - fm) : WGM;
        u.pm = fm + ((wgid % nig) % gsz); u.pn = (wgid % nig) / gsz; u.e = 0; u.ui = i; return true;
    }
    __device__ __forceinline__ size_t a_off(const Unit& u) const { return (size_t)u.pm * BM * rb; }
    __device__ __forceinline__ size_t b_off(const Unit& u) const { return (size_t)u.pn * BM * rb; }
};
struct GroupedOrder {
    int nM, nN, nwg, G, c, rb; const LAS int* tab; size_t bexp;
    __device__ void init(int nM_, int N, int rb_, int G_, int c_, const LAS int* tab_, size_t bexp_) { nM = nM_; nN = N / BM; nwg = nM * nN; G = G_; c = c_; rb = rb_; tab = tab_; bexp = bexp_; }
    __device__ __forceinline__ bool next(int i, Unit& u) const {
        const long L = (long)i * G + c; if (L >= nwg) return false;
        int wgid = (int)L; { const int q = nwg / NXCD, r = nwg % NXCD, xcd = wgid % NXCD, off = wgid / NXCD; wgid = (xcd < r ? xcd * (q + 1) : r * (q + 1) + (xcd - r) * q) + off; }
        const int nig = WGM * nN, gid = wgid / nig, fm = gid * WGM, gsz = (nM - fm) < WGM ? (nM - fm) : WGM;
        u.pm = fm + ((wgid % nig) % gsz); u.pn = (wgid % nig) / gsz; u.e = __builtin_amdgcn_readfirstlane(tab[u.pm]); u.ui = i; return true;
    }
    __device__ __forceinline__ size_t a_off(const Unit& u) const { return (size_t)u.pm * BM * rb; }
    __device__ __forceinline__ size_t b_off(const Unit& u) const { return (size_t)u.e * bexp + (size_t)u.pn * BM * rb; }
};

struct EpiQKV {
    static constexpr bool PERM = true;
    bf16_t* O; size_t stride; float qscale;
    __device__ __forceinline__ void operator()(const f32x4 (&acc)[2][2][4][2], const Unit& u, int wr, int wc, int fr, int fq) const {
        const int t = u.pn >> 1; bf16_t* base = O + (size_t)t * stride; const float sc = (t == 1) ? qscale : 1.f;
        const int row0 = u.pm * BM + wr * 64 + fr, col0 = (u.pn & 1) * BM + wc * 32 + 8 * fq;
#pragma unroll
        for (int ai = 0; ai < 2; ++ai)
#pragma unroll
            for (int m = 0; m < 4; ++m) { bf16_t* rowp = base + (size_t)(row0 + ai * HALF + m * 16) * 512 + col0;
#pragma unroll
                for (int bj = 0; bj < 2; ++bj) { const f32x4 v0 = acc[ai][bj][m][0] * sc, v1 = acc[ai][bj][m][1] * sc;
                    u32x4 w; w.x = pkbf(v0[0], v0[1]); w.y = pkbf(v0[2], v0[3]); w.z = pkbf(v1[0], v1[1]); w.w = pkbf(v1[2], v1[3]);
                    *(u32x4*)(rowp + bj * HALF) = w; } }
    }
};
struct EpiResF32 {
    static constexpr bool PERM = false;
    const float* base; float* out;
    __device__ __forceinline__ void operator()(const f32x4 (&acc)[2][2][4][2], const Unit& u, int wr, int wc, int fr, int fq) const {
        const int col0 = u.pn * BM + wc * 32 + 4 * fq;
#pragma unroll
        for (int ai = 0; ai < 2; ++ai)
#pragma unroll
            for (int m = 0; m < 4; ++m) { const size_t off = (size_t)(u.pm * BM + ai * HALF + wr * 64 + m * 16 + fr) * 1024 + col0;
#pragma unroll
                for (int bj = 0; bj < 2; ++bj)
#pragma unroll
                    for (int n = 0; n < 2; ++n) { const f32x4 bs = *(const f32x4*)(base + off + bj * HALF + n * 16); *(f32x4*)(out + off + bj * HALF + n * 16) = bs + acc[ai][bj][m][n]; } }
    }
};
struct EpiSwiGLU {
    static constexpr bool PERM = true;
    unsigned char* O; const float* bgu; const LAS float* rs;
    __device__ __forceinline__ void operator()(const f32x4 (&acc)[2][2][4][2], const Unit& u, int wr, int wc, int fr, int fq) const {
        const int row0 = u.pm * BM + wr * 64 + fr, jc0 = wc * 32 + 8 * fq;
        const float* bg = bgu + (size_t)u.e * 2048 + u.pn * 128 + jc0; const float* bl = bg + 1024;
        f32x4 bgv[2], blv[2];
#pragma unroll
        for (int n = 0; n < 2; ++n) { bgv[n] = *(const f32x4*)(bg + 4 * n); blv[n] = *(const f32x4*)(bl + 4 * n); }
        const int odd = fq & 1;
        unsigned char* cbase = O + (size_t)(row0 + odd * 16) * 1024 + u.pn * 128 + wc * 32 + 8 * (fq - odd);
#pragma unroll
        for (int ai = 0; ai < 2; ++ai)
#pragma unroll
            for (int mp = 0; mp < 2; ++mp) {
                u32x2 w2[2];
#pragma unroll
                for (int mm = 0; mm < 2; ++mm) { const int m = 2 * mp + mm;
                    const float rsc = rs[u.ui * 256 + wr * 64 + fr + ai * HALF + m * 16] * (1.0f / (W_SCALE * XS_SCALE));
                    float a[8];
#pragma unroll
                    for (int n = 0; n < 2; ++n) { const f32x4 g4 = acc[ai][0][m][n] * rsc + bgv[n], l4 = acc[ai][1][m][n] * rsc + blv[n];
#pragma unroll
                        for (int j = 0; j < 4; ++j) { const float gate = fminf(g4[j], 7.0f); const float lin = fminf(fmaxf(l4[j], -7.0f), 7.0f);
                            const float sg = __builtin_amdgcn_rcpf(1.0f + __builtin_amdgcn_exp2f(gate * (-1.702f * 1.4426950408889634f)));
                            a[4 * n + j] = gate * sg * (lin + 1.0f) * ACT_SCALE; } }
                    w2[mm].x = pk4f8(a[0], a[1], a[2], a[3]); w2[mm].y = pk4f8(a[4], a[5], a[6], a[7]); }
                const auto sx = __builtin_amdgcn_permlane16_swap(w2[0].x, w2[1].x, false, false), sy = __builtin_amdgcn_permlane16_swap(w2[0].y, w2[1].y, false, false);
                u32x4 o; o.x = sx[0]; o.y = sy[0]; o.z = sx[1]; o.w = sy[1];
                *(u32x4*)(cbase + (size_t)(ai * HALF + mp * 32) * 1024) = o; }
    }
};
struct EpiBiasBf16 {
    static constexpr bool PERM = true;
    unsigned char* O; const float* bias;
    __device__ __forceinline__ void operator()(const f32x4 (&acc)[2][2][4][2], const Unit& u, int wr, int wc, int fr, int fq) const {
        const int row0 = u.pm * BM + wr * 64 + fr, col0 = u.pn * BM + wc * 32 + 8 * fq;
        const float* bp = bias + (size_t)u.e * 1024 + col0;
        f32x4 bv[2][2];
#pragma unroll
        for (int bj = 0; bj < 2; ++bj)
#pragma unroll
            for (int n = 0; n < 2; ++n) bv[bj][n] = *(const f32x4*)(bp + bj * HALF + 4 * n);
        const int odd = fq & 1;
        unsigned char* cbase = O + (size_t)(row0 + odd * 16) * 1024 + u.pn * BM + wc * 32 + 8 * (fq - odd);
#pragma unroll
        for (int ai = 0; ai < 2; ++ai)
#pragma unroll
            for (int mp = 0; mp < 2; ++mp)
#pragma unroll
                for (int bj = 0; bj < 2; ++bj) {
                    u32x2 w2[2];
#pragma unroll
                    for (int mm = 0; mm < 2; ++mm) { const int m = 2 * mp + mm;
                        const f32x4 v0 = (acc[ai][bj][m][0] * (1.0f / (W_SCALE * ACT_SCALE)) + bv[bj][0]) * Y_SCALE, v1 = (acc[ai][bj][m][1] * (1.0f / (W_SCALE * ACT_SCALE)) + bv[bj][1]) * Y_SCALE;
                        w2[mm].x = pk4f8(v0[0], v0[1], v0[2], v0[3]); w2[mm].y = pk4f8(v1[0], v1[1], v1[2], v1[3]); }
                    const auto sx = __builtin_amdgcn_permlane16_swap(w2[0].x, w2[1].x, false, false), sy = __builtin_amdgcn_permlane16_swap(w2[0].y, w2[1].y, false, false);
                    u32x4 o; o.x = sx[0]; o.y = sy[0]; o.z = sx[1]; o.w = sy[1];
                    *(u32x4*)(cbase + (size_t)(ai * HALF + mp * 32) * 1024 + bj * HALF) = o; }
    }
};

template <class Epi, class Sched, bool ALIGN_EPI>
__device__ __forceinline__ void gemm_phase(LAS unsigned char* lds, const Gemm g, const Sched& S, const Epi& E) {
    const int tid = threadIdx.x, wid = __builtin_amdgcn_readfirstlane(tid >> 6), lane = tid & 63, wr = wid >> 2, wc = wid & 3, fr = lane & 15, fq = lane >> 4;
    const int K = g.K, nt = K / BK;
    unsigned voffA, voffB;
    { int R, C; stage_rc(tid * 16, R, C); const int Rb = Epi::PERM ? ((R & ~31) + perm32(R & 31)) : R;
        voffA = (unsigned)(R * K + C) * 2u; voffB = (unsigned)(Rb * K + C) * 2u; }
    const size_t pstep = (size_t)64 * K * 2;
    const size_t kstep = (size_t)(BK * 2);
    const size_t hstep = (size_t)HALF * K * 2;
    const unsigned ldsw = (unsigned)wid * 1024u;
    const int aoff = lds_byte(wr * 64 + fr, fq * 8), boff = lds_byte(wc * 32 + fr, fq * 8);
#define PG8_SA(b, h) (((b) * 2 + (h)) * HTB)
#define PG8_SB(b, h) ((4 + (b) * 2 + (h)) * HTB)
#define PG8_STAGE(bufoff, gbase, voff) do { _Pragma("unroll") for (int _i = 0; _i < 2; ++_i) \
        __builtin_amdgcn_global_load_lds((const unsigned*)((const char*)(gbase) + _i * pstep + (voff)), (LAS unsigned*)(lds + (bufoff) + ldsw + _i * 8192), 16, 0, 0); } while (0)
#define PG8_LDA(dst, b, h) do { _Pragma("unroll") for (int m = 0; m < 4; ++m) _Pragma("unroll") for (int k = 0; k < 2; ++k) dst[m][k] = *(const LAS bf16x8*)(lds + PG8_SA(b, h) + aoff + m * 2048 + k * 1024); } while (0)
#define PG8_LDB(dst, b, h) do { _Pragma("unroll") for (int n = 0; n < 2; ++n) _Pragma("unroll") for (int k = 0; k < 2; ++k) dst[n][k] = *(const LAS bf16x8*)(lds + PG8_SB(b, h) + boff + n * 2048 + k * 1024); } while (0)
#define PG8_MMA(ai, bj, At, Bt) do { __builtin_amdgcn_s_setprio(1); _Pragma("unroll") for (int m = 0; m < 4; ++m) _Pragma("unroll") for (int n = 0; n < 2; ++n) _Pragma("unroll") for (int k = 0; k < 2; ++k) \
        acc[ai][bj][m][n] = __builtin_amdgcn_mfma_f32_16x16x32_bf16(Bt[n][k], At[m][k], acc[ai][bj][m][n], 0, 0, 0); __builtin_amdgcn_s_setprio(0); } while (0)
#define PG8_WAIT_V(n) asm volatile("s_waitcnt vmcnt(" #n ")" ::: "memory")
#define PG8_WAIT_L(n) asm volatile("s_waitcnt lgkmcnt(" #n ")" ::: "memory")
#define PG8_BAR __builtin_amdgcn_s_barrier()
#define PG8_SCHED __builtin_amdgcn_sched_barrier(0)
    Unit cur, nxt; int ui = 0;
    if (!S.next(0, cur)) return;
    f32x4 acc[2][2][4][2];
#pragma unroll
    for (int a = 0; a < 2; ++a)
#pragma unroll
        for (int b = 0; b < 2; ++b)
#pragma unroll
            for (int m = 0; m < 4; ++m)
#pragma unroll
                for (int n = 0; n < 2; ++n) acc[a][b][m][n] = (f32x4){0.f, 0.f, 0.f, 0.f};
    bf16x8 At[4][2], B0[2][2], B1[2][2];
    const char* cA = (const char*)g.A + S.a_off(cur); const char* cB = (const char*)g.Bt + S.b_off(cur);
    PG8_STAGE(PG8_SB(0, 0), cB, voffB); PG8_STAGE(PG8_SB(0, 1), cB + hstep, voffB); PG8_STAGE(PG8_SA(0, 0), cA, voffA); PG8_STAGE(PG8_SA(0, 1), cA + hstep, voffA);
    if (wr == 1) PG8_BAR;
    PG8_WAIT_V(2); PG8_BAR;
    PG8_STAGE(PG8_SB(1, 0), cB + kstep, voffB); PG8_STAGE(PG8_SA(1, 0), cA + kstep, voffA); PG8_STAGE(PG8_SB(1, 1), cB + hstep + kstep, voffB);
    PG8_WAIT_V(6); PG8_BAR;
    for (;;) {
        const bool has_next = S.next(ui + 1, nxt);
        const char* nA = has_next ? (const char*)g.A + S.a_off(nxt) : cA; const char* nB = has_next ? (const char*)g.Bt + S.b_off(nxt) : cB;
#pragma nounroll
        for (int t = 0; t < nt; t += 2) {
            const bool last = (t == nt - 2);
            const char* a1 = cA + (size_t)(t + 1) * kstep;
            const char* a2 = last ? nA : cA + (size_t)(t + 2) * kstep; const char* b2 = last ? nB : cB + (size_t)(t + 2) * kstep;
            const char* a3 = a2 + kstep; const char* b3 = b2 + kstep;
            PG8_LDB(B0, 0, 0); PG8_LDB(B1, 0, 1); PG8_SCHED; PG8_LDA(At, 0, 0); PG8_STAGE(PG8_SA(1, 1), a1 + hstep, voffA);
            PG8_WAIT_V(8); PG8_WAIT_L(0); PG8_BAR; PG8_MMA(0, 0, At, B0); PG8_MMA(0, 1, At, B1); PG8_BAR; PG8_SCHED;
            PG8_LDA(At, 0, 1); PG8_STAGE(PG8_SB(0, 0), b2, voffB); PG8_STAGE(PG8_SB(0, 1), b2 + hstep, voffB); PG8_STAGE(PG8_SA(0, 0), a2, voffA);
            PG8_WAIT_V(8); PG8_WAIT_L(0); PG8_BAR; PG8_MMA(1, 0, At, B0); PG8_MMA(1, 1, At, B1); PG8_BAR; PG8_SCHED;
            PG8_LDB(B0, 1, 0); PG8_LDB(B1, 1, 1); PG8_SCHED; PG8_LDA(At, 1, 0); PG8_STAGE(PG8_SA(0, 1), a2 + hstep, voffA);
            PG8_WAIT_V(8); PG8_WAIT_L(0); PG8_BAR; PG8_MMA(0, 0, At, B0); PG8_MMA(0, 1, At, B1); PG8_BAR; PG8_SCHED;
            PG8_LDA(At, 1, 1); PG8_STAGE(PG8_SB(1, 0), b3, voffB); PG8_STAGE(PG8_SB(1, 1), b3 + hstep, voffB); PG8_STAGE(PG8_SA(1, 0), a3, voffA);
            PG8_WAIT_V(8); PG8_WAIT_L(0); PG8_BAR; PG8_MMA(1, 0, At, B0); PG8_MMA(1, 1, At, B1); PG8_BAR; PG8_SCHED;
        }
        if constexpr (ALIGN_EPI) { if (wr == 0) PG8_BAR; }
        E(acc, cur, wr, wc, fr, fq);
        if (!has_next) break;
#pragma unroll
        for (int a = 0; a < 2; ++a)
#pragma unroll
            for (int b = 0; b < 2; ++b)
#pragma unroll
                for (int m = 0; m < 4; ++m)
#pragma unroll
                    for (int n = 0; n < 2; ++n) acc[a][b][m][n] = (f32x4){0.f, 0.f, 0.f, 0.f};
        cur = nxt; cA = nA; cB = nB; ++ui;
        if constexpr (ALIGN_EPI) { if (wr == 1) PG8_BAR; }
    }
    PG8_WAIT_V(0);
    if constexpr (!ALIGN_EPI) { if (wr == 0) PG8_BAR; }
    PG8_BAR;
#undef PG8_SA
#undef PG8_SB
#undef PG8_STAGE
#undef PG8_LDA
#undef PG8_LDB
#undef PG8_MMA
#undef PG8_WAIT_V
#undef PG8_WAIT_L
#undef PG8_BAR
#undef PG8_SCHED
}
__host__ __device__ __forceinline__ int f8swz(int r) { return ((r >> 2) & 1) | (((r >> 1) & 1) << 2); }
struct Gemm8 { const unsigned char* A; const unsigned char* Bt; int Kb; };
template <class Epi, class Sched, bool ALIGN_EPI, bool GATHER = false>
__device__ __forceinline__ void gemm_phase_f8(LAS unsigned char* lds, const Gemm8 g, const Sched& S, const Epi& E, const LAS int* rowtab = nullptr) {
    const int tid = threadIdx.x, wid = __builtin_amdgcn_readfirstlane(tid >> 6), lane = tid & 63, wr = wid >> 2, wc = wid & 3, fr = lane & 15, fq = lane >> 4;
    const int Kb = g.Kb, nt = Kb / 128;
    unsigned voffA, voffB;
    { const int b = tid * 16, R = b >> 7, c = ((b >> 4) & 7) ^ f8swz(R & 15); const int Rb = Epi::PERM ? ((R & ~31) + perm32(R & 31)) : R;
        voffA = (unsigned)(R * Kb + 16 * c); voffB = (unsigned)(Rb * Kb + 16 * c); }
    const size_t pstep = (size_t)64 * Kb;
    const size_t kstep = 128;
    const int gc16 = 16 * ((tid & 7) ^ f8swz((tid >> 3) & 15));
    unsigned offC[2][2], offN[2][2];
#define PG8_ROWOFF(dst, uidx) do { _Pragma("unroll") for (int _h = 0; _h < 2; ++_h) _Pragma("unroll") for (int _i = 0; _i < 2; ++_i) dst[_h][_i] = (unsigned)(rowtab[(uidx) * 256 + _h * 128 + _i * 64 + (tid >> 3)] + gc16); } while (0)
#define PG8_STAGE_G(bufoff, kbyte, offs, h) do { _Pragma("unroll") for (int _i = 0; _i < 2; ++_i) \
        __builtin_amdgcn_global_load_lds((const unsigned*)((const char*)g.A + (kbyte) + (offs)[h][_i]), (LAS unsigned*)(lds + (bufoff) + ldsw + _i * 8192), 16, 0, 0); } while (0)
#define PG8_STAGE_A(b, h, ptr, kbyte, offs) do { if constexpr (GATHER) PG8_STAGE_G(PG8_SA(b, h), kbyte, offs, h); else PG8_STAGE(PG8_SA(b, h), (ptr) + (h) * hstep, voffA); } while (0)
    const size_t hstep = (size_t)HALF * Kb;
    const unsigned ldsw = (unsigned)wid * 1024u;
    LAS unsigned char* ab0 = lds + 128 * (wr * 64 + fr) + 16 * ((2 * fq) ^ f8swz(fr)); LAS unsigned char* ab1 = lds + 128 * (wr * 64 + fr) + 16 * ((2 * fq + 1) ^ f8swz(fr));
    LAS unsigned char* bb0 = lds + 65536 + 128 * (wc * 32 + fr) + 16 * ((2 * fq) ^ f8swz(fr)); LAS unsigned char* bb1 = lds + 65536 + 128 * (wc * 32 + fr) + 16 * ((2 * fq + 1) ^ f8swz(fr));
    asm volatile("" : "+v"(ab0), "+v"(ab1), "+v"(bb0), "+v"(bb1));
#define PG8_SA(b, h) (((b) * 2 + (h)) * HTB)
#define PG8_SB(b, h) ((4 + (b) * 2 + (h)) * HTB)
#define PG8_STAGE(bufoff, gbase, voff) do { _Pragma("unroll") for (int _i = 0; _i < 2; ++_i) \
        __builtin_amdgcn_global_load_lds((const unsigned*)((const char*)(gbase) + _i * pstep + (voff)), (LAS unsigned*)(lds + (bufoff) + ldsw + _i * 8192), 16, 0, 0); } while (0)
#define PG8_LDA(dst, b, h) do { _Pragma("unroll") for (int m = 0; m < 4; ++m) { dst[m][0] = *(const LAS u32x4*)(ab0 + PG8_SA(b, h) + m * 2048); dst[m][1] = *(const LAS u32x4*)(ab1 + PG8_SA(b, h) + m * 2048); } } while (0)
#define PG8_LDB(dst, b, h) do { _Pragma("unroll") for (int n = 0; n < 2; ++n) { dst[n][0] = *(const LAS u32x4*)(bb0 + PG8_SA(b, h) + n * 2048); dst[n][1] = *(const LAS u32x4*)(bb1 + PG8_SA(b, h) + n * 2048); } } while (0)
#define PG8_CAT(x) __builtin_bit_cast(v8i32, __builtin_shufflevector((x)[0], (x)[1], 0, 1, 2, 3, 4, 5, 6, 7))
#define PG8_MMA(ai, bj, At, Bt) do { __builtin_amdgcn_s_setprio(1); _Pragma("unroll") for (int m = 0; m < 4; ++m) _Pragma("unroll") for (int n = 0; n < 2; ++n) \
        asm volatile("v_mfma_f32_16x16x128_f8f6f4 %0, %1, %2, %0" : "+v"(acc[ai][bj][m][n]) : "v"(PG8_CAT(Bt[n])), "v"(PG8_CAT(At[m]))); __builtin_amdgcn_s_setprio(0); } while (0)
#define PG8_WAIT_V(n) asm volatile("s_waitcnt vmcnt(" #n ")" ::: "memory")
#define PG8_WAIT_L(n) asm volatile("s_waitcnt lgkmcnt(" #n ")" ::: "memory")
#define PG8_BAR __builtin_amdgcn_s_barrier()
#define PG8_SCHED __builtin_amdgcn_sched_barrier(0)
    Unit cur, nxt; int ui = 0;
    if (!S.next(0, cur)) return;
    f32x4 acc[2][2][4][2];
#pragma unroll
    for (int a = 0; a < 2; ++a)
#pragma unroll
        for (int b = 0; b < 2; ++b)
#pragma unroll
            for (int m = 0; m < 4; ++m)
#pragma unroll
                for (int n = 0; n < 2; ++n) acc[a][b][m][n] = (f32x4){0.f, 0.f, 0.f, 0.f};
    u32x4 At[4][2], B0[2][2], B1[2][2];
    const char* cA = (const char*)g.A + (GATHER ? 0 : S.a_off(cur)); const char* cB = (const char*)g.Bt + S.b_off(cur);
    if constexpr (GATHER) { PG8_ROWOFF(offC, 0); }
    PG8_STAGE(PG8_SB(0, 0), cB, voffB); PG8_STAGE(PG8_SB(0, 1), cB + hstep, voffB); PG8_STAGE_A(0, 0, cA, 0, offC); PG8_STAGE_A(0, 1, cA, 0, offC);
    if (wr == 1) PG8_BAR;
    PG8_WAIT_V(2); PG8_BAR;
    PG8_STAGE(PG8_SB(1, 0), cB + kstep, voffB); PG8_STAGE_A(1, 0, cA + kstep, 128, offC); PG8_STAGE(PG8_SB(1, 1), cB + hstep + kstep, voffB);
    PG8_WAIT_V(6); PG8_BAR;
    for (;;) {
        const bool has_next = S.next(ui + 1, nxt);
        const char* nA = (has_next && !GATHER) ? (const char*)g.A + S.a_off(nxt) : cA; const char* nB = has_next ? (const char*)g.Bt + S.b_off(nxt) : cB;
        if constexpr (GATHER) { if (has_next) { PG8_ROWOFF(offN, ui + 1); } else {
#pragma unroll
            for (int _h = 0; _h < 2; ++_h)
#pragma unroll
                for (int _i = 0; _i < 2; ++_i) offN[_h][_i] = offC[_h][_i]; } }
#pragma nounroll
        for (int t = 0; t < nt; t += 2) {
            const bool last = (t == nt - 2);
            const char* a1 = cA + (size_t)(t + 1) * kstep;
            const char* a2 = last ? nA : cA + (size_t)(t + 2) * kstep; const char* b2 = last ? nB : cB + (size_t)(t + 2) * kstep;
            const char* a3 = a2 + kstep; const char* b3 = b2 + kstep;
            const int kb1 = (t + 1) * 128, kb2 = last ? 0 : (t + 2) * 128, kb3 = kb2 + 128;
            unsigned off2[2][2];
            if constexpr (GATHER) {
#pragma unroll
                for (int _h = 0; _h < 2; ++_h)
#pragma unroll
                    for (int _i = 0; _i < 2; ++_i) off2[_h][_i] = last ? offN[_h][_i] : offC[_h][_i]; }
            PG8_LDB(B0, 0, 0); PG8_LDB(B1, 0, 1); PG8_SCHED; PG8_LDA(At, 0, 0); PG8_STAGE_A(1, 1, a1, kb1, offC);
            PG8_WAIT_V(8); PG8_WAIT_L(0); PG8_BAR; PG8_MMA(0, 0, At, B0); PG8_MMA(0, 1, At, B1); PG8_BAR; PG8_SCHED;
            PG8_LDA(At, 0, 1); PG8_STAGE(PG8_SB(0, 0), b2, voffB); PG8_STAGE(PG8_SB(0, 1), b2 + hstep, voffB); PG8_STAGE_A(0, 0, a2, kb2, off2);
            PG8_WAIT_V(8); PG8_WAIT_L(0); PG8_BAR; PG8_MMA(1, 0, At, B0); PG8_MMA(1, 1, At, B1); PG8_BAR; PG8_SCHED;
            PG8_LDB(B0, 1, 0); PG8_LDB(B1, 1, 1); PG8_SCHED; PG8_LDA(At, 1, 0); PG8_STAGE_A(0, 1, a2, kb2, off2);
            PG8_WAIT_V(8); PG8_WAIT_L(0); PG8_BAR; PG8_MMA(0, 0, At, B0); PG8_MMA(0, 1, At, B1); PG8_BAR; PG8_SCHED;
            PG8_LDA(At, 1, 1); PG8_STAGE(PG8_SB(1, 0), b3, voffB); PG8_STAGE(PG8_SB(1, 1), b3 + hstep, voffB); PG8_STAGE_A(1, 0, a3, kb3, off2);
            PG8_WAIT_V(8); PG8_WAIT_L(0); PG8_BAR; PG8_MMA(1, 0, At, B0); PG8_MMA(1, 1, At, B1); PG8_BAR; PG8_SCHED;
        }
        if constexpr (ALIGN_EPI) { if (wr == 0) PG8_BAR; }
        asm volatile("s_nop 15\n\ts_nop 7" ::: "memory");
        E(acc, cur, wr, wc, fr, fq);
        if (!has_next) break;
#pragma unroll
        for (int a = 0; a < 2; ++a)
#pragma unroll
            for (int b = 0; b < 2; ++b)
#pragma unroll
                for (int m = 0; m < 4; ++m)
#pragma unroll
                    for (int n = 0; n < 2; ++n) acc[a][b][m][n] = (f32x4){0.f, 0.f, 0.f, 0.f};
        cur = nxt; cA = nA; cB = nB; ++ui;
        if constexpr (GATHER) {
#pragma unroll
            for (int _h = 0; _h < 2; ++_h)
#pragma unroll
                for (int _i = 0; _i < 2; ++_i) offC[_h][_i] = offN[_h][_i]; }
        if constexpr (ALIGN_EPI) { if (wr == 1) PG8_BAR; }
    }
    PG8_WAIT_V(0);
    if constexpr (!ALIGN_EPI) { if (wr == 0) PG8_BAR; }
    PG8_BAR;
#undef PG8_ROWOFF
#undef PG8_STAGE_G
#undef PG8_STAGE_A
#undef PG8_SA
#undef PG8_SB
#undef PG8_STAGE
#undef PG8_LDA
#undef PG8_LDB
#undef PG8_CAT
#undef PG8_MMA
#undef PG8_WAIT_V
#undef PG8_WAIT_L
#undef PG8_BAR
#undef PG8_SCHED
}
}

constexpr size_t MiB = 1u << 20;
constexpr size_t WS_CTL = 0, CTL_ZERO_BYTES = 1 * MiB;
constexpr size_t WS_WIN = 1 * MiB, WS_WO = 5 * MiB;
constexpr size_t WS_TAB = 7 * MiB;
constexpr size_t WS_TOPI = 8 * MiB, WS_GATE = WS_TOPI + 256 * 1024, WS_LRANK = WS_GATE + 256 * 1024, WS_POS = WS_LRANK + 256 * 1024;
constexpr size_t WS_RSTD = 12 * MiB, WS_INV = 13 * MiB;
constexpr int CW_CNT = 256;
constexpr size_t WS_ML = 9 * MiB;
constexpr size_t WS_WGU = 16 * MiB, WS_WD = 144 * MiB, WS_XN = 208 * MiB;
constexpr size_t WS_U = 240 * MiB, WS_Q = 256 * MiB, WS_K = 272 * MiB, WS_V = 288 * MiB;
constexpr size_t WS_OB = 304 * MiB, WS_MIX = 352 * MiB, WS_XMID = 384 * MiB, WS_XS = 448 * MiB, WS_ACT = 592 * MiB, WS_Y = 736 * MiB, WS_END = 880 * MiB;
constexpr int CW_BAR = 4096;

constexpr int RING_BYTES = 131072, LDSCTL_OFF = RING_BYTES, MISC_OFF = LDSCTL_OFF + 320;
constexpr int LDS_NMT_OFF = LDSCTL_OFF + 512, LDS_TAB_OFF = LDSCTL_OFF + 1024, LDS_TOPI_OFF = LDSCTL_OFF + 4096, LDS_P6_OFF = LDSCTL_OFF + 8192, LDS_G_OFF = LDSCTL_OFF + 8192, LDS_ROWT_OFF = LDSCTL_OFF + 12288;
constexpr int MAX_UNITS = 10;
constexpr int LDS_RSTB_OFF = LDS_ROWT_OFF + MAX_UNITS * 1024;
constexpr int LDS_BYTES = 163840;

#define XB_TMO      128
#define XB_XCNT(j)  (256  + 64 * (j))
#define XB_XSUB(j)  (1280 + 64 * (j))
#define XB_XGEN(j)  (2304 + 64 * (j))
#define XB_TOP      3328
#define XB_TOPGEN   3392
#define XCD_BAR_WORDS 3456
#define XB_SPIN_CAP (1u << 18)
__device__ __forceinline__ unsigned xb_ld(unsigned* p)              { return __hip_atomic_load(p, __ATOMIC_RELAXED, __HIP_MEMORY_SCOPE_AGENT); }
__device__ __forceinline__ unsigned xb_add(unsigned* p, unsigned v) { return __hip_atomic_fetch_add(p, v, __ATOMIC_RELAXED, __HIP_MEMORY_SCOPE_AGENT); }
__device__ __forceinline__ unsigned xb_xcc_id() { return (unsigned)__builtin_amdgcn_s_getreg((3 << 11) | 20) & 0xFu; }
#define XB_SPIN(cond, bar) do { unsigned _sp = 0; while (cond) { __builtin_amdgcn_s_sleep(1); \
    if ((++_sp & 255u) == 0u) { if (xb_ld(&(bar)[XB_TMO])) break; if (_sp > XB_SPIN_CAP) { atomicAdd(&(bar)[XB_TMO], 1u); break; } } } } while (0)
struct XcdBarrier { unsigned* bar; unsigned x; volatile LAS unsigned* st; };
__device__ __forceinline__ XcdBarrier xcd_barrier_post(unsigned* bar, volatile LAS unsigned* st) {
    XcdBarrier b; b.bar = bar; b.x = xb_xcc_id(); b.st = st;
    if (threadIdx.x == 0) (void)xb_add(&bar[XB_XCNT(b.x)], 1u);
    return b;
}
__device__ __forceinline__ void xcd_barrier_complete(unsigned* bar, unsigned x, unsigned& nloc, unsigned& nx) {
    const unsigned G = gridDim.x * gridDim.y * gridDim.z;
    unsigned sum, cnt, mine, sp = 0u;
    for (;;) {
        sum = 0u; cnt = 0u; mine = 0u;
#pragma unroll
        for (unsigned j = 0; j < 16; ++j) { const unsigned c = xb_ld(&bar[XB_XCNT(j)]); sum += c; cnt += (c > 0u) ? 1u : 0u; mine = (j == x) ? c : mine; }
        if (sum == G) break;
        __builtin_amdgcn_s_sleep(1);
        if ((++sp & 255u) == 0u) { if (xb_ld(&bar[XB_TMO])) break; if (sp > XB_SPIN_CAP) { atomicAdd(&bar[XB_TMO], 1u); break; } }
    }
    nloc = mine > 0u ? mine : 1u; nx = cnt > 0u ? cnt : 1u;
}
__device__ __forceinline__ void xcd_barrier(const XcdBarrier& b) {
    asm volatile("s_waitcnt vmcnt(0)" ::: "memory");
    __syncthreads();
    if (threadIdx.x == 0) {
        unsigned* bar = b.bar;
        __builtin_amdgcn_s_waitcnt(0);
        unsigned nloc = b.st[0], nx = b.st[1];
        if (nloc == 0u) { xcd_barrier_complete(bar, b.x, nloc, nx); b.st[0] = nloc; b.st[1] = nx; }
        const unsigned old = xb_add(&bar[XB_XSUB(b.x)], 1u);
        const unsigned gen = old / nloc;
        if (old + 1u == (gen + 1u) * nloc) {
            __builtin_amdgcn_fence(__ATOMIC_RELEASE, "agent");
            asm volatile("s_waitcnt vmcnt(0)" ::: "memory");
            const unsigned og = xb_add(&bar[XB_TOP], 1u);
            const unsigned tg = og / nx;
            if (og + 1u == (tg + 1u) * nx) xb_add(&bar[XB_TOPGEN], 1u);
            else XB_SPIN(xb_ld(&bar[XB_TOPGEN]) == tg, bar);
            __builtin_amdgcn_fence(__ATOMIC_ACQUIRE, "agent");
            xb_add(&bar[XB_XGEN(b.x)], 1u);
            asm volatile("s_waitcnt vmcnt(0)" ::: "memory");
        } else {
            XB_SPIN(xb_ld(&bar[XB_XGEN(b.x)]) == gen, bar);
            __builtin_amdgcn_fence(__ATOMIC_ACQUIRE, "agent");
            asm volatile("s_waitcnt vmcnt(0)" ::: "memory");
        }
    }
    __syncthreads();
}

__device__ __forceinline__ float wave_sum(float v) {
#pragma unroll
    for (int o = 1; o < 64; o <<= 1) v += __shfl_xor(v, o);
    return v;
}
__device__ __forceinline__ void rms_row_to_bf16(const float* xrow, const float* g, bf16_t* orow, int lane) {
    const f32x4* xr = (const f32x4*)xrow + lane; const f32x4* gr = (const f32x4*)g + lane;
    f32x4 v[4]; float s = 0.f;
#pragma unroll
    for (int j = 0; j < 4; ++j) { v[j] = xr[64 * j]; s += (v[j].x * v[j].x + v[j].y * v[j].y) + (v[j].z * v[j].z + v[j].w * v[j].w); }
    const float rstd = 1.0f / sqrtf(wave_sum(s) * (1.f / D) + EPS);
    u32x2* o8 = (u32x2*)orow + lane;
#pragma unroll
    for (int j = 0; j < 4; ++j) { const f32x4 gv = gr[64 * j]; u32x2 w; w.x = pkbf(v[j].x * rstd * gv.x, v[j].y * rstd * gv.y); w.y = pkbf(v[j].z * rstd * gv.z, v[j].w * rstd * gv.w); o8[64 * j] = w; }
}
__device__ __forceinline__ void transpose64(const float* W, int ldn, bf16_t* WT, int ldk, int k0, int n0, int drow0, int dcol0, LAS unsigned char* scr, int lane) {
    const int nc = lane & 15, kq = lane >> 4;
    const float* src = W + (size_t)(k0 + 16 * kq) * ldn + n0 + 4 * nc;
    f32x4 v[16];
#pragma unroll
    for (int it = 0; it < 16; ++it) v[it] = *(const f32x4*)(src + (size_t)it * ldn);
    const int x = nc & 7;
#pragma unroll
    for (int c = 0; c < 4; ++c) { const int n = 4 * nc + c;
        u32x4 lo, hi;
        lo.x = pkbf(v[0][c], v[1][c]); lo.y = pkbf(v[2][c], v[3][c]); lo.z = pkbf(v[4][c], v[5][c]); lo.w = pkbf(v[6][c], v[7][c]);
        hi.x = pkbf(v[8][c], v[9][c]); hi.y = pkbf(v[10][c], v[11][c]); hi.z = pkbf(v[12][c], v[13][c]); hi.w = pkbf(v[14][c], v[15][c]);
        *(LAS u32x4*)(scr + 128 * n + 16 * ((2 * kq) ^ x)) = lo;
        *(LAS u32x4*)(scr + 128 * n + 16 * ((2 * kq + 1) ^ x)) = hi; }
#pragma unroll
    for (int j = 0; j < 8; ++j) { const int n = (lane >> 3) + 8 * j, c = lane & 7, xx = (n >> 2) & 7;
        const u32x4 o = *(const LAS u32x4*)(scr + 128 * n + 16 * (c ^ xx));
        *(u32x4*)(WT + (size_t)(drow0 + n) * ldk + dcol0 + 8 * c) = o; }
}
__device__ __forceinline__ void weff_item(const float* w_pool, const float* pool_scale, const float* w_out, bf16_t* WoT, int item, LAS float* scr, int lane) {
    const int nb = item & 15, cb = (item >> 4) & 15, g = item >> 8;
#pragma unroll
    for (int q = 0; q < 16; ++q) { const int idx = lane + 64 * q, i = idx >> 7, dp = idx & 127; scr[idx] = w_pool[(size_t)(g * 128 + 8 * cb + i) * 128 + dp] * pool_scale[g * 128 + dp]; }
    float acc[8];
#pragma unroll
    for (int i = 0; i < 8; ++i) acc[i] = 0.f;
    const float* wo = w_out + (size_t)(g * 128) * 1024 + nb * 64 + lane;
    for (int dp = 0; dp < 128; dp += 4) {
        const float w0 = wo[(size_t)(dp + 0) * 1024], w1 = wo[(size_t)(dp + 1) * 1024], w2 = wo[(size_t)(dp + 2) * 1024], w3 = wo[(size_t)(dp + 3) * 1024];
#pragma unroll
        for (int i = 0; i < 8; ++i) { const f32x4 s = *(const LAS f32x4*)(scr + i * 128 + dp); acc[i] += (s.x * w0 + s.y * w1) + (s.z * w2 + s.w * w3); }
    }
    u32x4 o; o.x = pkbf(acc[0], acc[1]); o.y = pkbf(acc[2], acc[3]); o.z = pkbf(acc[4], acc[5]); o.w = pkbf(acc[6], acc[7]);
    *(u32x4*)(WoT + (size_t)(nb * 64 + lane) * 1024 + g * 128 + 8 * cb) = o;
}

constexpr int I_GU = 32 * 8 * 32, I_DN = 32 * 8 * 16, N_WITEMS = I_GU + I_DN;
struct WItem { const float* src; unsigned char* dst; int ldn; };
__device__ __forceinline__ WItem witem_decode(int r, const float* w_gu, const float* w_down, unsigned char* WguT, unsigned char* WdT) {
    WItem w;
    if (r < I_GU) { const int e = r >> 8, kb = (r >> 5) & 7, nb = r & 31, n0 = 64 * nb;
        const int drow = (n0 < 1024) ? ((n0 >> 7) * 256 + (n0 & 127)) : (((n0 - 1024) >> 7) * 256 + 128 + ((n0 - 1024) & 127));
        w.src = w_gu + (size_t)e * 1024 * 2048 + (size_t)(128 * kb) * 2048 + n0; w.dst = WguT + (size_t)e * 2048 * 1024 + (size_t)drow * 1024 + 128 * kb; w.ldn = 2048; }
    else { r -= I_GU; const int e = r >> 7, kb = (r >> 4) & 7, nb = r & 15;
        w.src = w_down + (size_t)e * 1024 * 1024 + (size_t)(128 * kb) * 1024 + 64 * nb; w.dst = WdT + (size_t)e * 1024 * 1024 + (size_t)(64 * nb) * 1024 + 128 * kb; w.ldn = 1024; }
    return w;
}
__device__ __forceinline__ void witem_issue(const WItem& w, int half, f32x4 (&v)[16], int lane) {
    const int nc = lane & 15, kq = lane >> 4;
    const float* src = w.src + (size_t)(32 * kq + 16 * half) * w.ldn + 4 * nc;
#pragma unroll
    for (int it = 0; it < 16; ++it) v[it] = __builtin_nontemporal_load((const f32x4*)(src + (size_t)it * w.ldn));
}
__device__ __forceinline__ void witem_finish(const WItem& w, int half, const f32x4 (&v)[16], LAS unsigned char* scr, int lane) {
    const int nc = lane & 15, kq = lane >> 4, x = nc & 7;
#pragma unroll
    for (int c = 0; c < 4; ++c) { const int n = 4 * nc + c;
        u32x4 q; q.x = pk4f8(v[0][c] * W_SCALE, v[1][c] * W_SCALE, v[2][c] * W_SCALE, v[3][c] * W_SCALE); q.y = pk4f8(v[4][c] * W_SCALE, v[5][c] * W_SCALE, v[6][c] * W_SCALE, v[7][c] * W_SCALE);
        q.z = pk4f8(v[8][c] * W_SCALE, v[9][c] * W_SCALE, v[10][c] * W_SCALE, v[11][c] * W_SCALE); q.w = pk4f8(v[12][c] * W_SCALE, v[13][c] * W_SCALE, v[14][c] * W_SCALE, v[15][c] * W_SCALE);
        *(LAS u32x4*)(scr + 128 * n + 16 * ((2 * kq + half) ^ x)) = q; }
    if (half == 1) {
#pragma unroll
        for (int j = 0; j < 8; ++j) { const int n = (lane >> 3) + 8 * j, c = lane & 7, xx = (n >> 2) & 7;
            const u32x4 o = *(const LAS u32x4*)(scr + 128 * n + 16 * (c ^ xx));
            __builtin_nontemporal_store(o, (u32x4*)(w.dst + (size_t)n * 1024 + 16 * c)); }
    }
}

struct AttU { int b, h, br, dil, r, n; };
__device__ __forceinline__ AttU att_decode(int u) {
    u = u % 3072; AttU a; const int bh = u / 48, sub = u % 48; a.b = bh >> 3; a.h = bh & 7; a.br = sub >> 4; const int j = sub & 15;
    if (a.br == 0) { a.dil = 1; a.r = 0; a.n = j; } else if (a.br == 1) { a.dil = 4; a.r = j >> 2; a.n = j & 3; } else { a.dil = 16; a.r = j; a.n = 0; }
    return a;
}
__device__ __forceinline__ void attn_phase(LAS unsigned char* lds, const bf16_t* Qb, const bf16_t* Kb, const bf16_t* Vb, bf16_t* OB, float* ML, int vcu, int G, int tid,
                                           const float* w_gu, const float* w_down, unsigned char* WguT, unsigned char* WdT) {
    constexpr int NU = 64 * 48 * DUPN(2);
    const int lane = tid & 63, wid = rfl(tid >> 6), i16 = lane & 15, fq = lane >> 4;
    const int gwv = vcu * 8 + wid, NGWv = G * 8;
    LAS unsigned char* wscr = lds + 65536 + wid * 8192;
    f32x4 wv[16]; WItem wi; wi.src = nullptr; wi.dst = nullptr; wi.ldn = 0;
    int step = 0;
    u32x4 kreg[4], vreg[4], qreg[2];
    int u = vcu;
    if (u < NU) { const AttU a = att_decode(u);
#pragma unroll
        for (int p = 0; p < 4; ++p) { const int q = tid + 512 * p, row = q >> 3, c = q & 7; int cp = (a.n - 1) * 128 + row; cp = cp < 0 ? 0 : cp;
            const size_t off = (size_t)(a.b * SEQ + cp * a.dil + a.r) * 512 + a.h * 64 + c * 8; kreg[p] = *(const u32x4*)(Kb + off); vreg[p] = *(const u32x4*)(Vb + off); }
        const bf16_t* qp = Qb + (size_t)(a.b * SEQ + (a.n * 128 + 16 * wid + i16) * a.dil + a.r) * 512 + a.h * 64 + 8 * fq;
        qreg[0] = *(const u32x4*)(qp); qreg[1] = *(const u32x4*)(qp + 32); }
    bool wact = (u < NU) && (gwv < N_WITEMS);
    if (wact) { wi = witem_decode(gwv, w_gu, w_down, WguT, WdT); witem_issue(wi, 0, wv, lane); }
    for (; u < NU; u += G, ++step) {
        const AttU a = att_decode(u);
#pragma unroll
        for (int p = 0; p < 4; ++p) { const int q = tid + 512 * p, row = q >> 3, c = q & 7;
            *(LAS u32x4*)(lds + 128 * row + 16 * (c ^ ((row >> 1) & 7))) = kreg[p];
            *(LAS u32x4*)(lds + 32768 + 128 * row + 32 * ((c >> 1) ^ ((row >> 1) & 3)) + 16 * (c & 1)) = vreg[p]; }
        const bf16x8 qf0 = __builtin_bit_cast(bf16x8, qreg[0]), qf1 = __builtin_bit_cast(bf16x8, qreg[1]);
        __syncthreads();
        const int un = u + G;
        if (un < NU) { const AttU a2 = att_decode(un);
#pragma unroll
            for (int p = 0; p < 4; ++p) { const int q = tid + 512 * p, row = q >> 3, c = q & 7; int cp = (a2.n - 1) * 128 + row; cp = cp < 0 ? 0 : cp;
                const size_t off = (size_t)(a2.b * SEQ + cp * a2.dil + a2.r) * 512 + a2.h * 64 + c * 8; kreg[p] = *(const u32x4*)(Kb + off); vreg[p] = *(const u32x4*)(Vb + off); }
            const bf16_t* qp = Qb + (size_t)(a2.b * SEQ + (a2.n * 128 + 16 * wid + i16) * a2.dil + a2.r) * 512 + a2.h * 64 + 8 * fq;
            qreg[0] = *(const u32x4*)(qp); qreg[1] = *(const u32x4*)(qp + 32); }
        asm volatile("" ::: "memory");
        const int qi = 16 * wid + i16;
        const size_t tokq = (size_t)(a.b * SEQ + (a.n * 128 + qi) * a.dil + a.r);
        f32x4 sc[9];
#pragma unroll
        for (int kt = 0; kt < 9; ++kt) { const int row = 16 * (wid + kt) + i16, xr = (row >> 1) & 7;
            const bf16x8 a0 = *(const LAS bf16x8*)(lds + 128 * row + 16 * (fq ^ xr)), a1 = *(const LAS bf16x8*)(lds + 128 * row + 16 * ((4 + fq) ^ xr));
            f32x4 z = (f32x4){0.f, 0.f, 0.f, 0.f};
            z = __builtin_amdgcn_mfma_f32_16x16x32_bf16(a0, qf0, z, 0, 0, 0);
            sc[kt] = __builtin_amdgcn_mfma_f32_16x16x32_bf16(a1, qf1, z, 0, 0, 0); }
        float mx = -1e30f;
#pragma unroll
        for (int kt = 0; kt < 9; ++kt)
#pragma unroll
            for (int j = 0; j < 4; ++j) { bool valid = true; if (kt == 0) valid = (i16 <= 4 * fq + j); if (kt == 8) valid = (4 * fq + j <= i16);
                if (a.n == 0 && wid + kt < 8) valid = false;
                const float s = valid ? sc[kt][j] : -1e30f; sc[kt][j] = s; mx = fmaxf(mx, s); }
        mx = fmaxf(mx, __shfl_xor(mx, 16)); mx = fmaxf(mx, __shfl_xor(mx, 32));
        float l = 0.f;
#pragma unroll
        for (int kt = 0; kt < 9; ++kt)
#pragma unroll
            for (int j = 0; j < 4; ++j) { const float p = __builtin_amdgcn_exp2f(sc[kt][j] - mx); sc[kt][j] = p; l += p; }
        l += __shfl_xor(l, 16); l += __shfl_xor(l, 32);
        f32x4 o[4];
#pragma unroll
        for (int dt = 0; dt < 4; ++dt) o[dt] = (f32x4){0.f, 0.f, 0.f, 0.f};
        const int qq = i16 >> 2, pp = i16 & 3;
#pragma unroll
        for (int sl = 0; sl < 5; ++sl) {
            const int row0 = 16 * (wid + 2 * sl) + 4 * fq + qq, row1 = (sl == 4) ? row0 : row0 + 16;
            u32x4 pw; pw.x = pkbf(sc[2 * sl][0], sc[2 * sl][1]); pw.y = pkbf(sc[2 * sl][2], sc[2 * sl][3]);
            if (sl < 4) { pw.z = pkbf(sc[(2 * sl + 1) % 9][0], sc[(2 * sl + 1) % 9][1]); pw.w = pkbf(sc[(2 * sl + 1) % 9][2], sc[(2 * sl + 1) % 9][3]); } else { pw.z = 0u; pw.w = 0u; }
            const bf16x8 pf = __builtin_bit_cast(bf16x8, pw);
#pragma unroll
            for (int dt = 0; dt < 4; ++dt) {
                const v4i16_t t0 = __builtin_amdgcn_ds_read_tr16_b64_v4i16((LAS v4i16_t*)(lds + 32768 + 128 * row0 + 32 * (dt ^ ((row0 >> 1) & 3)) + 8 * pp));
                const v4i16_t t1 = __builtin_amdgcn_ds_read_tr16_b64_v4i16((LAS v4i16_t*)(lds + 32768 + 128 * row1 + 32 * (dt ^ ((row1 >> 1) & 3)) + 8 * pp));
                const bf16x8 af = (bf16x8){t0[0], t0[1], t0[2], t0[3], t1[0], t1[1], t1[2], t1[3]};
                o[dt] = __builtin_amdgcn_mfma_f32_16x16x32_bf16(af, pf, o[dt], 0, 0, 0);
            }
        }
        const float inv = 1.0f / l;
        bf16_t* op = OB + ((size_t)a.br * T + tokq) * 512 + a.h * 64 + 4 * fq;
#pragma unroll
        for (int dt = 0; dt < 4; ++dt) { u32x2 w; w.x = pkbf(o[dt][0] * inv, o[dt][1] * inv); w.y = pkbf(o[dt][2] * inv, o[dt][3] * inv); *(u32x2*)(op + 16 * dt) = w; }
        if (fq == 0) { f32x2 ml; ml.x = mx; ml.y = l; *(f32x2*)(ML + (((size_t)a.br * T + tokq) * 8 + a.h) * 2) = ml; }
        if (wact) witem_finish(wi, step & 1, wv, wscr, lane);
        {
            const int ns = step + 1, nitem = gwv + (ns >> 1) * NGWv; const bool nact = (u + G < NU) && (nitem < N_WITEMS);
            if (nact) { if ((ns & 1) == 0) wi = witem_decode(nitem, w_gu, w_down, WguT, WdT); witem_issue(wi, ns & 1, wv, lane); }
            wact = nact;
        }
        __syncthreads();
    }
    if (step & 1) { const int witem = gwv + (step >> 1) * NGWv; if (witem < N_WITEMS) { witem_issue(wi, 1, wv, lane); witem_finish(wi, 1, wv, wscr, lane); } ++step; }
    for (int witem = gwv + (step >> 1) * NGWv; witem < N_WITEMS; witem += NGWv) { wi = witem_decode(witem, w_gu, w_down, WguT, WdT);
        witem_issue(wi, 0, wv, lane); witem_finish(wi, 0, wv, wscr, lane); witem_issue(wi, 1, wv, lane); witem_finish(wi, 1, wv, wscr, lane); }
}

struct Args { const float* in[14]; float* out; unsigned char* ws; };
constexpr int NWAVES = 8;

__global__ void __launch_bounds__(NWAVES * 64, 2) mega_fwd(Args args) {
    extern __shared__ __attribute__((aligned(16))) unsigned char lds_raw[];
    LAS unsigned char* lds = (LAS unsigned char*)lds_raw;
    volatile LAS unsigned* MISC = (volatile LAS unsigned*)(lds + MISC_OFF);
    const int tid = threadIdx.x, lane = tid & 63, wave = rfl(tid >> 6);
    const int G = gridDim.x; const int bx = blockIdx.x; const int vcu = (G % 8 == 0) ? (bx % 8) * (G / 8) + bx / 8 : bx;
    unsigned char* ws = args.ws;
    const float* x = args.in[0]; const float* g_mix = args.in[1]; const float* w_in = args.in[2]; const float* w_pool = args.in[3]; const float* pool_scale = args.in[4];
    const float* w_out = args.in[5]; const float* g_ffn = args.in[6]; const float* w_router = args.in[7]; const float* b_router = args.in[8];
    const float* w_gu = args.in[9]; const float* b_gu = args.in[10]; const float* w_down = args.in[11]; const float* b_down = args.in[12]; const float* g_final = args.in[13];
    float* out = args.out;
    bf16_t* WinT = (bf16_t*)(ws + WS_WIN); bf16_t* WoT = (bf16_t*)(ws + WS_WO); unsigned char* WguT = ws + WS_WGU; unsigned char* WdT = ws + WS_WD;
    bf16_t* XN = (bf16_t*)(ws + WS_XN); bf16_t* Ub = (bf16_t*)(ws + WS_U); bf16_t* Qb = (bf16_t*)(ws + WS_Q); bf16_t* Kb = (bf16_t*)(ws + WS_K); bf16_t* Vb = (bf16_t*)(ws + WS_V);
    bf16_t* OB = (bf16_t*)(ws + WS_OB); float* ML = (float*)(ws + WS_ML); bf16_t* MIX = (bf16_t*)(ws + WS_MIX); float* XMID = (float*)(ws + WS_XMID);
    unsigned char* XS = ws + WS_XS; unsigned char* ACT = ws + WS_ACT; unsigned char* Yb = ws + WS_Y;
    int* TOPI = (int*)(ws + WS_TOPI); float* GATE = (float*)(ws + WS_GATE); int* LRANK = (int*)(ws + WS_LRANK);
    unsigned* CNT = (unsigned*)(ws + WS_CTL) + CW_CNT; int* INV = (int*)(ws + WS_INV);

    for (int u = tid; u < (LDS_BYTES - LDSCTL_OFF) / 4; u += NWAVES * 64) ((LAS unsigned*)(lds + LDSCTL_OFF))[u] = 0u;
    __syncthreads();
    XcdBarrier bar = xcd_barrier_post((unsigned*)(ws + WS_CTL) + CW_BAR, MISC + 8);
    const int gw = vcu * NWAVES + wave, NGW = G * NWAVES;

    {
        LAS unsigned char* scr = lds + wave * 16384;
        constexpr int I_IN = 16 * 32, I_OUT = 8 * 16, NITEMS = I_IN + I_OUT;
        for (int it = gw; it < NITEMS; it += NGW) {
            int r = it;
            if (r < I_IN) { const int kb = r >> 5, nb = r & 31; transpose64(w_in, 2048, WinT, 1024, 64 * kb, 64 * nb, 64 * nb, 64 * kb, scr, lane); continue; } r -= I_IN;
            { const int kb = r >> 4, nb = r & 15; transpose64(w_out + (size_t)512 * 1024, 1024, WoT, 1024, 64 * kb, 64 * nb, 64 * nb, 512 + 64 * kb, scr, lane); }
        }
        for (int q = gw * 64 + lane; q < 4096; q += NGW * 64) { const int e = q & 31, k8 = q >> 5;
            float wv[8], rv[8];
#pragma unroll
            for (int j = 0; j < 8; ++j) wv[j] = w_router[(size_t)(8 * k8 + j) * 32 + e];
            u32x4 H; H.x = pkbf(wv[0], wv[1]); H.y = pkbf(wv[2], wv[3]); H.z = pkbf(wv[4], wv[5]); H.w = pkbf(wv[6], wv[7]);
            rv[0] = wv[0] - bflo(H.x); rv[1] = wv[1] - bfhi(H.x); rv[2] = wv[2] - bflo(H.y); rv[3] = wv[3] - bfhi(H.y); rv[4] = wv[4] - bflo(H.z); rv[5] = wv[5] - bfhi(H.z); rv[6] = wv[6] - bflo(H.w); rv[7] = wv[7] - bfhi(H.w);
            u32x4 L; L.x = pkbf(rv[0], rv[1]); L.y = pkbf(rv[2], rv[3]); L.z = pkbf(rv[4], rv[5]); L.w = pkbf(rv[6], rv[7]);
            *(u32x4*)(ws + WS_TAB + 2048 * e + 16 * (k8 ^ (e & 15))) = H; *(u32x4*)(ws + WS_TAB + 65536 + 2048 * e + 16 * (k8 ^ (e & 15))) = L; }
        for (int it = gw; it < DUPN(10) * 1024; it += NGW) weff_item(w_pool, pool_scale, w_out, WoT, it & 1023, (LAS float*)scr, lane);
        for (int m = gw; m < DUPN(11) * T; m += NGW) rms_row_to_bf16(x + (size_t)(m & (T - 1)) * D, g_mix, XN + (size_t)(m & (T - 1)) * D, lane);
    }
    xcd_barrier(bar);

    {
        pg8::Gemm g{XN, WinT, D}; pg8::StaticOrder S; S.init(T, 2048, D * 2, G, bx);
        pg8::EpiQKV E{Ub, (size_t)T * 512, QSCALE};
        pg8::gemm_phase<pg8::EpiQKV, pg8::StaticOrder, true>(lds, g, S, E);
    }
    xcd_barrier(bar);
#if (PROBE_DUP >> 1) & 1
    {
        pg8::Gemm g{XN, WinT, D}; pg8::StaticOrder S; S.init(T, 2048, D * 2, G, bx);
        pg8::EpiQKV E{Ub, (size_t)T * 512, QSCALE};
        pg8::gemm_phase<pg8::EpiQKV, pg8::StaticOrder, true>(lds, g, S, E);
    }
    xcd_barrier(bar);
#endif

    attn_phase(lds, Qb, Kb, Vb, OB, ML, vcu, G, tid, w_gu, w_down, WguT, WdT);
    xcd_barrier(bar);

    for (int run_ = gw; run_ < DUPN(3) * (T / 8); run_ += NGW) {
        const int run = run_ & (T / 8 - 1);
        const int t0 = run * 8, ts0 = t0 & (SEQ - 1), grp = lane >> 4, w = 2 << grp;
        u32x4 cur[8], old[8];
#pragma unroll
        for (int i = 0; i < 8; ++i) { cur[i] = *(const u32x4*)(Ub + (size_t)(t0 + i) * 512 + 8 * lane);
            const int to = (ts0 + i >= w - 1) ? (t0 + i - w + 1) : (t0 + i);
            old[i] = *(const u32x4*)(Ub + (size_t)to * 512 + 8 * lane); }
        float S[8];
#pragma unroll
        for (int i = 0; i < 8; ++i) S[i] = 0.f;
#pragma unroll
        for (int j = 1; j < 16; ++j) {
            if (j < w && j <= ts0) { const u32x4 v = *(const u32x4*)(Ub + (size_t)(t0 - j) * 512 + 8 * lane);
                S[0] += bflo(v.x); S[1] += bfhi(v.x); S[2] += bflo(v.y); S[3] += bfhi(v.y); S[4] += bflo(v.z); S[5] += bfhi(v.z); S[6] += bflo(v.w); S[7] += bfhi(v.w); }
        }
#pragma unroll
        for (int i = 0; i < 8; ++i) {
            const int t = t0 + i, ts = ts0 + i;
            const float c0 = bflo(cur[i].x), c1 = bfhi(cur[i].x), c2 = bflo(cur[i].y), c3 = bfhi(cur[i].y), c4 = bflo(cur[i].z), c5 = bfhi(cur[i].z), c6 = bflo(cur[i].w), c7 = bfhi(cur[i].w);
            S[0] += c0; S[1] += c1; S[2] += c2; S[3] += c3; S[4] += c4; S[5] += c5; S[6] += c6; S[7] += c7;
            const int cnt = (ts + 1 < w) ? ts + 1 : w; const float ic = 1.0f / (float)cnt;
            u32x4 pw; pw.x = pkbf(S[0] * ic - c0, S[1] * ic - c1); pw.y = pkbf(S[2] * ic - c2, S[3] * ic - c3); pw.z = pkbf(S[4] * ic - c4, S[5] * ic - c5); pw.w = pkbf(S[6] * ic - c6, S[7] * ic - c7);
            *(u32x4*)(MIX + (size_t)t * 1024 + 8 * lane) = pw;
            if (ts >= w - 1) { const u32x4 v = old[i];
                S[0] -= bflo(v.x); S[1] -= bfhi(v.x); S[2] -= bflo(v.y); S[3] -= bfhi(v.y); S[4] -= bflo(v.z); S[5] -= bfhi(v.z); S[6] -= bflo(v.w); S[7] -= bfhi(v.w); }
        }
        const int h = lane >> 3;
#pragma unroll
        for (int bt = 0; bt < 2; ++bt) {
            f32x2 mlv[4][3]; u32x4 ov[4][3];
#pragma unroll
            for (int i = 0; i < 4; ++i)
#pragma unroll
                for (int br = 0; br < 3; ++br) { const int t = t0 + 4 * bt + i;
                    mlv[i][br] = *(const f32x2*)(ML + (((size_t)br * T + t) * 8 + h) * 2); ov[i][br] = *(const u32x4*)(OB + ((size_t)br * T + t) * 512 + 8 * lane); }
#pragma unroll
            for (int i = 0; i < 4; ++i) { const int t = t0 + 4 * bt + i;
                const float mall = fmaxf(mlv[i][0].x, fmaxf(mlv[i][1].x, mlv[i][2].x));
                float w0 = mlv[i][0].y * __builtin_amdgcn_exp2f(mlv[i][0].x - mall), w1 = mlv[i][1].y * __builtin_amdgcn_exp2f(mlv[i][1].x - mall), w2 = mlv[i][2].y * __builtin_amdgcn_exp2f(mlv[i][2].x - mall);
                const float it = 1.0f / (w0 + w1 + w2); w0 *= it; w1 *= it; w2 *= it;
                const u32x4 o0 = ov[i][0], o1 = ov[i][1], o2 = ov[i][2];
                u32x4 aw;
                aw.x = pkbf(w0 * bflo(o0.x) + w1 * bflo(o1.x) + w2 * bflo(o2.x), w0 * bfhi(o0.x) + w1 * bfhi(o1.x) + w2 * bfhi(o2.x));
                aw.y = pkbf(w0 * bflo(o0.y) + w1 * bflo(o1.y) + w2 * bflo(o2.y), w0 * bfhi(o0.y) + w1 * bfhi(o1.y) + w2 * bfhi(o2.y));
                aw.z = pkbf(w0 * bflo(o0.z) + w1 * bflo(o1.z) + w2 * bflo(o2.z), w0 * bfhi(o0.z) + w1 * bfhi(o1.z) + w2 * bfhi(o2.z));
                aw.w = pkbf(w0 * bflo(o0.w) + w1 * bflo(o1.w) + w2 * bflo(o2.w), w0 * bfhi(o0.w) + w1 * bfhi(o1.w) + w2 * bfhi(o2.w));
                *(u32x4*)(MIX + (size_t)t * 1024 + 512 + 8 * lane) = aw; }
        }
    }
    xcd_barrier(bar);

#if (PROBE_DUP >> 14) & 1
    {
        unsigned* CHK = (unsigned*)(ws + WS_CTL) + 2;
        for (int s_ = gw; s_ < 700 * 8; s_ += NGW) {
            const int si = s_ >> 3, h = s_ & 7;
            const int t = (si < 256) ? ((si >> 5) * SEQ + (si & 31) * ((si & 1) ? 1 : 9)) % T : (int)(((long)si * 7919) % T);
            const int ts = t & (SEQ - 1), b = t >> 11;
            float sc[3][3]; float mx = -1e30f;
#pragma unroll
            for (int br = 0; br < 3; ++br) { const int dil = (br == 0) ? 1 : (br == 1 ? 4 : 16);
#pragma unroll
                for (int c = 0; c < 3; ++c) { const int j = lane + 64 * c; float s = -1e30f;
                    if (j <= 128 && j <= ts / dil) { const int tk = b * SEQ + ts - j * dil; float acc = 0.f;
                        for (int d = 0; d < 64; ++d) acc += __uint_as_float((unsigned)Qb[(size_t)t * 512 + h * 64 + d] << 16) * __uint_as_float((unsigned)Kb[(size_t)tk * 512 + h * 64 + d] << 16);
                        s = acc; }
                    sc[br][c] = s; mx = fmaxf(mx, s); } }
#pragma unroll
            for (int o = 1; o < 64; o <<= 1) mx = fmaxf(mx, __shfl_xor(mx, o));
            float lsum = 0.f;
#pragma unroll
            for (int br = 0; br < 3; ++br)
#pragma unroll
                for (int c = 0; c < 3; ++c) { sc[br][c] = __builtin_amdgcn_exp2f(sc[br][c] - mx); lsum += sc[br][c]; }
            lsum = wave_sum(lsum);
            float ov = 0.f;
#pragma unroll
            for (int br = 0; br < 3; ++br) { const int dil = (br == 0) ? 1 : (br == 1 ? 4 : 16);
#pragma unroll
                for (int c = 0; c < 3; ++c)
                    for (int l2 = 0; l2 < 64; ++l2) { const int j = l2 + 64 * c; const float p = __shfl(sc[br][c], l2);
                        if (j <= 128 && j <= ts / dil) { const int tk = b * SEQ + ts - j * dil; ov += p * __uint_as_float((unsigned)Vb[(size_t)tk * 512 + h * 64 + lane] << 16); } } }
            ov /= lsum;
            const float got = __uint_as_float((unsigned)MIX[(size_t)t * 1024 + 512 + h * 64 + lane] << 16);
            bool bad = !(fabsf(got - ov) <= 0.004f + 0.02f * fabsf(ov));
            { const int ch = h * 64 + lane, grp = ch >> 7, w = 2 << grp; const int cnt = (ts + 1 < w) ? ts + 1 : w; float sm = 0.f;
              for (int j = 0; j < cnt; ++j) sm += __uint_as_float((unsigned)Ub[(size_t)(t - j) * 512 + ch] << 16);
              const float pv = sm / (float)cnt - __uint_as_float((unsigned)Ub[(size_t)t * 512 + ch] << 16);
              const float gp = __uint_as_float((unsigned)MIX[(size_t)t * 1024 + ch] << 16);
              bad = bad || !(fabsf(gp - pv) <= 0.004f + 0.02f * fabsf(pv)); }
            if (__any(bad) && lane == 0) atomicAdd(CHK, 1u);
        }
    }
    xcd_barrier(bar);
#endif
    {
        pg8::Gemm g{MIX, WoT, D}; pg8::StaticOrder S; S.init(T, D, D * 2, G, bx);
        pg8::EpiResF32 E{x, XMID};
        pg8::gemm_phase<pg8::EpiResF32, pg8::StaticOrder, true>(lds, g, S, E);
    }
    xcd_barrier(bar);
#if (PROBE_DUP >> 4) & 1
    {
        pg8::Gemm g{MIX, WoT, D}; pg8::StaticOrder S; S.init(T, D, D * 2, G, bx);
        pg8::EpiResF32 E{x, XMID};
        pg8::gemm_phase<pg8::EpiResF32, pg8::StaticOrder, true>(lds, g, S, E);
    }
    xcd_barrier(bar);
#endif

    {
        {
            const u32x4* wri = (const u32x4*)(ws + WS_TAB);
#pragma unroll
            for (int p = 0; p < 16; ++p) *(LAS u32x4*)(lds + (tid + 512 * p) * 16) = wri[tid + 512 * p];
        }
        LAS float* lgf = (LAS float*)(lds + LDS_G_OFF);
        lgf[tid] = g_ffn[tid]; lgf[tid + 512] = g_ffn[tid + 512];
        __syncthreads();
        LAS int* ltopi = (LAS int*)(lds + LDS_TOPI_OFF);
        unsigned char* XG8 = ws + WS_XS; float* RSTD = (float*)(ws + WS_RSTD);
        const int i16 = lane & 15, fq = lane >> 4, ti = i16 & 7;
        if (bx == 0 && wave == 0) *(u32x4*)(XG8 + (size_t)T * 1024 + 16 * lane) = (u32x4){0u, 0u, 0u, 0u};
        float brv[8];
#pragma unroll
        for (int j = 0; j < 8; ++j) brv[j] = b_router[16 * (j >> 2) + 4 * fq + (j & 3)];
        for (int blk_ = vcu; blk_ < (T / 64); blk_ += G) {
            const int blk = blk_ & 255;
            {
                const int tl = 8 * wave + ti, t = 64 * blk + tl;
                const float* xr = XMID + (size_t)t * 1024 + 8 * fq;
                f32x4 acc0 = (f32x4){0.f, 0.f, 0.f, 0.f}, acc1 = (f32x4){0.f, 0.f, 0.f, 0.f}; float ssq = 0.f;
#pragma unroll 8
                for (int ks = 0; ks < 32; ++ks) {
                    const f32x4 xa = *(const f32x4*)(xr + 32 * ks), xb = *(const f32x4*)(xr + 32 * ks + 4);
                    const f32x4 ga = *(const LAS f32x4*)(lgf + 32 * ks + 8 * fq), gb = *(const LAS f32x4*)(lgf + 32 * ks + 8 * fq + 4);
                    ssq += (xa.x * xa.x + xa.y * xa.y) + (xa.z * xa.z + xa.w * xa.w) + (xb.x * xb.x + xb.y * xb.y) + (xb.z * xb.z + xb.w * xb.w);
                    const f32x4 ya = xa * ga, yb = xb * gb;
                    u32x4 H; H.x = pkbf(ya.x, ya.y); H.y = pkbf(ya.z, ya.w); H.z = pkbf(yb.x, yb.y); H.w = pkbf(yb.z, yb.w);
                    u32x4 L; L.x = pkbf(ya.x - bflo(H.x), ya.y - bfhi(H.x)); L.y = pkbf(ya.z - bflo(H.y), ya.w - bfhi(H.y)); L.z = pkbf(yb.x - bflo(H.z), yb.y - bfhi(H.z)); L.w = pkbf(yb.z - bflo(H.w), yb.w - bfhi(H.w));
                    u32x2 f8; f8.x = pk4f8(ya.x * XS_SCALE, ya.y * XS_SCALE, ya.z * XS_SCALE, ya.w * XS_SCALE); f8.y = pk4f8(yb.x * XS_SCALE, yb.y * XS_SCALE, yb.z * XS_SCALE, yb.w * XS_SCALE);
                    if (i16 < 8) *(u32x2*)(XG8 + (size_t)t * 1024 + 32 * ks + 8 * fq) = f8;
                    const bf16x8 xh = __builtin_bit_cast(bf16x8, H), xl = __builtin_bit_cast(bf16x8, L);
                    const int ch = 4 * ks + fq;
                    const bf16x8 wh0 = *(const LAS bf16x8*)(lds + 2048 * i16 + 16 * (ch ^ i16)), wl0 = *(const LAS bf16x8*)(lds + 65536 + 2048 * i16 + 16 * (ch ^ i16));
                    const bf16x8 wh1 = *(const LAS bf16x8*)(lds + 2048 * (16 + i16) + 16 * (ch ^ i16)), wl1 = *(const LAS bf16x8*)(lds + 65536 + 2048 * (16 + i16) + 16 * (ch ^ i16));
                    acc0 = __builtin_amdgcn_mfma_f32_16x16x32_bf16(wh0, xh, acc0, 0, 0, 0); acc1 = __builtin_amdgcn_mfma_f32_16x16x32_bf16(wh1, xh, acc1, 0, 0, 0);
                    acc0 = __builtin_amdgcn_mfma_f32_16x16x32_bf16(wl0, xh, acc0, 0, 0, 0); acc1 = __builtin_amdgcn_mfma_f32_16x16x32_bf16(wl1, xh, acc1, 0, 0, 0);
                    acc0 = __builtin_amdgcn_mfma_f32_16x16x32_bf16(wh0, xl, acc0, 0, 0, 0); acc1 = __builtin_amdgcn_mfma_f32_16x16x32_bf16(wh1, xl, acc1, 0, 0, 0);
                }
                ssq += __shfl_xor(ssq, 16); ssq += __shfl_xor(ssq, 32);
                const float rstd = 1.0f / sqrtf(ssq * (1.f / D) + EPS);
                float my[8];
#pragma unroll
                for (int r = 0; r < 4; ++r) { my[r] = acc0[r] * rstd + brv[r]; my[4 + r] = acc1[r] * rstd + brv[4 + r]; }
                float lg[32];
#pragma unroll
                for (int f = 0; f < 4; ++f)
#pragma unroll
                    for (int j = 0; j < 8; ++j) lg[16 * (j >> 2) + 4 * f + (j & 3)] = __shfl(my[j], i16 + 16 * f);
                unsigned taken = 0u; float tv[4]; int tix[4];
#pragma unroll
                for (int r = 0; r < 4; ++r) { float best = -3.0e38f; int bi = 0;
#pragma unroll
                    for (int e = 0; e < 32; ++e) { const bool ok = !((taken >> e) & 1u) && (lg[e] > best); best = ok ? lg[e] : best; bi = ok ? e : bi; }
                    taken |= 1u << bi; tv[r] = best; tix[r] = bi; }
                const float e1 = __expf(tv[1] - tv[0]), e2 = __expf(tv[2] - tv[0]), e3 = __expf(tv[3] - tv[0]); const float is = 1.0f / (1.0f + e1 + e2 + e3);
                if (lane < 8) { *(int4*)(TOPI + (size_t)t * 4) = make_int4(tix[0], tix[1], tix[2], tix[3]); *(f32x4*)(GATE + (size_t)t * 4) = (f32x4){is, e1 * is, e2 * is, e3 * is};
                    RSTD[t] = rstd;
                    ltopi[tl * 4 + 0] = tix[0]; ltopi[tl * 4 + 1] = tix[1]; ltopi[tl * 4 + 2] = tix[2]; ltopi[tl * 4 + 3] = tix[3]; }
            }
            __syncthreads();
            if (wave == 0) {
                const int e0 = ltopi[lane * 4 + 0], e1 = ltopi[lane * 4 + 1], e2 = ltopi[lane * 4 + 2], e3 = ltopi[lane * 4 + 3];
                int r0 = 0, r1 = 0, r2 = 0, r3 = 0, mycnt = 0; const unsigned long long below = (1ull << lane) - 1ull;
                for (int e = 0; e < 32; ++e) { const bool hit = (e0 == e) | (e1 == e) | (e2 == e) | (e3 == e); const unsigned long long mk = __ballot(hit); const int rk = __popcll(mk & below);
                    if (e0 == e) r0 = rk; if (e1 == e) r1 = rk; if (e2 == e) r2 = rk; if (e3 == e) r3 = rk; if (lane == e) mycnt = __popcll(mk); }
                int base = 0; if (lane < 32) base = (int)__hip_atomic_fetch_add(CNT + lane, (unsigned)mycnt, __ATOMIC_RELAXED, __HIP_MEMORY_SCOPE_AGENT);
                r0 += __shfl(base, e0); r1 += __shfl(base, e1); r2 += __shfl(base, e2); r3 += __shfl(base, e3);
                const int tt = 64 * blk + lane;
                *(int4*)(LRANK + (size_t)tt * 4) = make_int4(r0, r1, r2, r3);
                INV[(size_t)e0 * T + r0] = tt; INV[(size_t)e1 * T + r1] = tt; INV[(size_t)e2 * T + r2] = tt; INV[(size_t)e3 * T + r3] = tt;
            }
            __syncthreads();
        }
    }
    xcd_barrier(bar);

    {
        LAS int* ltab = (LAS int*)(lds + LDS_TAB_OFF); LAS int* lnmt = (LAS int*)(lds + LDS_NMT_OFF);
        LAS int* lcnt = (LAS int*)(lds + LDS_P6_OFF), * lO = lcnt + 32;
        LAS int* lrow = (LAS int*)(lds + LDS_ROWT_OFF); LAS float* lrs = (LAS float*)(lds + LDS_RSTB_OFF);
        if (tid < 32) lcnt[tid] = (int)__hip_atomic_load(CNT + tid, __ATOMIC_RELAXED, __HIP_MEMORY_SCOPE_AGENT);
        __syncthreads();
        if (tid == 0) { int off = 0; for (int e = 0; e < 32; ++e) { lO[e] = off; off += ((lcnt[e] + 255) >> 8) << 8; } lO[32] = off; lnmt[0] = off >> 8; }
        __syncthreads();
        const int nmt = rfl(lnmt[0]);
        for (int mt = tid; mt < nmt && mt < 384; mt += NWAVES * 64) { int e = 0; for (int q = 1; q < 32; ++q) e += (lO[q] <= mt * 256) ? 1 : 0; ltab[mt] = e; }
        __syncthreads();
        {
            pg8::GroupedOrder S0; S0.init(nmt, 2048, D, G, bx, ltab, (size_t)2048 * 1024); pg8::Unit u0;
            const float* RSTD = (const float*)(ws + WS_RSTD);
            for (int i = 0; i < MAX_UNITS && S0.next(i, u0); ++i) if (tid < 256) {
                const int e = u0.e, rk = u0.pm * 256 - lO[e] + tid; const bool valid = rk < lcnt[e];
                const int tok = valid ? INV[(size_t)e * T + rk] : T;
                lrow[i * 256 + tid] = tok * 1024; lrs[i * 256 + tid] = valid ? RSTD[tok] : 0.f; }
        }
        __syncthreads();
        {
            pg8::Gemm8 g{XS, WguT, D}; pg8::GroupedOrder S; S.init(nmt, 2048, D, G, bx, ltab, (size_t)2048 * 1024);
            pg8::EpiSwiGLU E{ACT, b_gu, lrs};
            pg8::gemm_phase_f8<pg8::EpiSwiGLU, pg8::GroupedOrder, true, true>(lds, g, S, E, lrow);
        }
        xcd_barrier(bar);
        {
            pg8::Gemm8 g{ACT, WdT, DE}; pg8::GroupedOrder S; S.init(nmt, 1024, DE, G, bx, ltab, (size_t)1024 * 1024);
            pg8::EpiBiasBf16 E{Yb, b_down};
            pg8::gemm_phase_f8<pg8::EpiBiasBf16, pg8::GroupedOrder, true>(lds, g, S, E);
        }
    }
    xcd_barrier(bar);

    {
        unsigned bad = __hip_atomic_load((unsigned*)(ws + WS_CTL) + CW_BAR + XB_TMO, __ATOMIC_RELAXED, __HIP_MEMORY_SCOPE_AGENT);
#if (PROBE_DUP >> 14) & 1
        bad |= __hip_atomic_load((unsigned*)(ws + WS_CTL) + 2, __ATOMIC_RELAXED, __HIP_MEMORY_SCOPE_AGENT);
#endif
        LAS int* lO9 = (LAS int*)(lds + LDS_P6_OFF) + 32;
        __syncthreads();
        if (tid == 0) { int off = 0; for (int e = 0; e < 32; ++e) { lO9[e] = off; off += (((int)__hip_atomic_load(CNT + e, __ATOMIC_RELAXED, __HIP_MEMORY_SCOPE_AGENT) + 255) >> 8) << 8; } }
        __syncthreads();
        for (int t_ = gw; t_ < DUPN(9) * T; t_ += NGW) {
            const int t = t_ & (T - 1);
            const int4 ee = *(const int4*)(TOPI + (size_t)t * 4), rk = *(const int4*)(LRANK + (size_t)t * 4);
            const int4 ps = make_int4(lO9[ee.x] + rk.x, lO9[ee.y] + rk.y, lO9[ee.z] + rk.z, lO9[ee.w] + rk.w); const f32x4 gt = *(const f32x4*)(GATE + (size_t)t * 4);
            const f32x4* xr = (const f32x4*)(XMID + (size_t)t * 1024) + lane; const f32x4* gr = (const f32x4*)g_final + lane;
            const unsigned* y0 = (const unsigned*)(Yb + (size_t)ps.x * 1024) + lane; const unsigned* y1 = (const unsigned*)(Yb + (size_t)ps.y * 1024) + lane;
            const unsigned* y2 = (const unsigned*)(Yb + (size_t)ps.z * 1024) + lane; const unsigned* y3 = (const unsigned*)(Yb + (size_t)ps.w * 1024) + lane;
            const f32x4 gs = gt * (1.0f / Y_SCALE);
            f32x4 v[4]; float s = 0.f;
#pragma unroll
            for (int j = 0; j < 4; ++j) { v[j] = xr[64 * j]; const int a = (int)y0[64 * j], b = (int)y1[64 * j], c = (int)y2[64 * j], d = (int)y3[64 * j];
                const f32x2 al = __builtin_amdgcn_cvt_pk_f32_fp8(a, false), ah = __builtin_amdgcn_cvt_pk_f32_fp8(a, true), bl = __builtin_amdgcn_cvt_pk_f32_fp8(b, false), bh = __builtin_amdgcn_cvt_pk_f32_fp8(b, true);
                const f32x2 cl = __builtin_amdgcn_cvt_pk_f32_fp8(c, false), chh = __builtin_amdgcn_cvt_pk_f32_fp8(c, true), dl = __builtin_amdgcn_cvt_pk_f32_fp8(d, false), dh = __builtin_amdgcn_cvt_pk_f32_fp8(d, true);
                v[j].x += gs.x * al.x + gs.y * bl.x + gs.z * cl.x + gs.w * dl.x;
                v[j].y += gs.x * al.y + gs.y * bl.y + gs.z * cl.y + gs.w * dl.y;
                v[j].z += gs.x * ah.x + gs.y * bh.x + gs.z * chh.x + gs.w * dh.x;
                v[j].w += gs.x * ah.y + gs.y * bh.y + gs.z * chh.y + gs.w * dh.y;
                s += (v[j].x * v[j].x + v[j].y * v[j].y) + (v[j].z * v[j].z + v[j].w * v[j].w); }
            float rstd = 1.0f / sqrtf(wave_sum(s) * (1.f / D) + EPS);
            if (bad) rstd = __builtin_nanf("");
            f32x4* orow = (f32x4*)(out + (size_t)t * 1024) + lane;
#pragma unroll
            for (int j = 0; j < 4; ++j) { const f32x4 gv = gr[64 * j]; orow[64 * j] = v[j] * rstd * gv; }
        }
    }
}

extern "C" void kernel_launch(void* const* d_in, const int* in_sizes, int n_in, void* d_out, int out_size, void* d_ws, size_t ws_size, hipStream_t stream) {
    static int grid = 0;
    if (grid == 0) {
        if (n_in != 14 || in_sizes[0] != T * D || out_size != T * D || ws_size < WS_END) { fprintf(stderr, "kernel_launch: unexpected shapes (n_in %d, in0 %d, out %d, ws %zu)\n", n_in, n_in > 0 ? in_sizes[0] : -1, out_size, ws_size); grid = -1; return; }
        int dev = 0, cus = 0, per_cu = 0;
        if (hipGetDevice(&dev) != hipSuccess || hipDeviceGetAttribute(&cus, hipDeviceAttributeMultiprocessorCount, dev) != hipSuccess) { grid = -1; return; }
        if (hipFuncSetAttribute((const void*)mega_fwd, hipFuncAttributeMaxDynamicSharedMemorySize, LDS_BYTES) != hipSuccess) { fprintf(stderr, "kernel_launch: hipFuncSetAttribute failed\n"); grid = -1; return; }
        if (hipOccupancyMaxActiveBlocksPerMultiprocessor(&per_cu, (const void*)mega_fwd, NWAVES * 64, LDS_BYTES) != hipSuccess || per_cu < 1)
            fprintf(stderr, "kernel_launch: note: occupancy query reports %d workgroups per CU\n", per_cu);
        (void)hipGetLastError();
        grid = cus;
    }
    if (grid < 0) return;
    if (hipMemsetAsync((char*)d_ws + WS_CTL, 0, CTL_ZERO_BYTES, stream) != hipSuccess) return;
    Args a{};
    for (int i = 0; i < 14; ++i) a.in[i] = (const float*)d_in[i];
    a.out = (float*)d_out; a.ws = (unsigned char*)d_ws;
    hipLaunchKernelGGL(mega_fwd, dim3(grid), dim3(NWAVES * 64), LDS_BYTES, stream, a);
}
```

```cpp
#include <hip/hip_runtime.h>
#include <cstdio>
#include <cstdint>
#ifndef PROBE_DUP
#define PROBE_DUP 0
#endif
#define DUPN(k) (((PROBE_DUP >> (k)) & 1) ? 2 : 1)

#define GAS __attribute__((address_space(1)))
#define LAS __attribute__((address_space(3)))
typedef unsigned short bf16_t;
typedef short bf16x8 __attribute__((ext_vector_type(8)));
typedef float f32x4 __attribute__((ext_vector_type(4)));
typedef float f32x2 __attribute__((ext_vector_type(2)));
typedef unsigned u32x4 __attribute__((ext_vector_type(4)));
typedef unsigned u32x2 __attribute__((ext_vector_type(2)));
typedef __bf16 bf16x2_t __attribute__((ext_vector_type(2)));
typedef short v4i16_t __attribute__((ext_vector_type(4)));

__device__ __forceinline__ unsigned pkbf(float lo, float hi) { f32x2 v = {lo, hi}; bf16x2_t b = __builtin_convertvector(v, bf16x2_t); return __builtin_bit_cast(unsigned, b); }
__device__ __forceinline__ float bflo(unsigned w) { return __uint_as_float(w << 16); }
__device__ __forceinline__ float bfhi(unsigned w) { return __uint_as_float(w & 0xffff0000u); }
__device__ __forceinline__ int rfl(int v) { return __builtin_amdgcn_readfirstlane(v); }

constexpr int T = 16384, D = 1024, SEQ = 2048, NH = 8, HD = 64, DP = 512, DA = 512, NE = 32, TOPK = 4, DE = 1024;
constexpr float EPS = 1e-5f;
constexpr int MAXROWS = 73728;
constexpr float QSCALE = 0.125f * 1.4426950408889634f;

constexpr float W_SCALE = 64.0f, XS_SCALE = 16.0f, ACT_SCALE = 4.0f, Y_SCALE = 16.0f;
__device__ __forceinline__ float clamp448(float v) { return fminf(fmaxf(v, -448.0f), 448.0f); }
__device__ __forceinline__ unsigned pk4f8(float a, float b, float c, float d) {
    int w = __builtin_amdgcn_cvt_pk_fp8_f32(clamp448(a), clamp448(b), 0, false);
    w = __builtin_amdgcn_cvt_pk_fp8_f32(clamp448(c), clamp448(d), w, true);
    return (unsigned)w;
}
typedef int v8i32 __attribute__((ext_vector_type(8)));
namespace pg8 {
constexpr int BM = 256, BK = 64, HALF = 128, HTB = HALF * BK * 2, STAGE_BYTES = 8 * HTB, NXCD = 8, WGM = 8;
__host__ __device__ __forceinline__ int lds_byte(int r, int c) { const int st = (r >> 4) * 2 + (c >> 5), rr = r & 15, cc = c & 31, ob = rr * 64 + cc * 2; return st * 1024 + (ob ^ (((ob >> 9) & 1) << 5)); }
__host__ __device__ __forceinline__ void stage_rc(int b, int& R, int& C) { const int st = b / 1024, sb = b % 1024, swz = sb ^ (((sb >> 9) & 1) << 5); R = (st >> 1) * 16 + swz / 64; C = (st & 1) * 32 + (swz % 64) / 2; }
__host__ __device__ __forceinline__ int perm32(int rho) { const int n = rho >> 4, i = rho & 15; return 8 * (i >> 2) + 4 * n + (i & 3); }

struct Unit { int pm, pn, e, ui; };
struct Gemm { const bf16_t* A; const bf16_t* Bt; int K; };

struct StaticOrder {
    int nM, nN, nwg, G, c, rb;
    __device__ void init(int M, int N, int rb_, int G_, int c_) { nM = M / BM; nN = N / BM; nwg = nM * nN; G = G_; c = c_; rb = rb_; }
    __device__ __forceinline__ bool next(int i, Unit& u) const {
        const long L = (long)i * G + c; if (L >= nwg) return false;
        int wgid = (int)L; { const int q = nwg / NXCD, r = nwg % NXCD, xcd = wgid % NXCD, off = wgid / NXCD; wgid = (xcd < r ? xcd * (q + 1) : r * (q + 1) + (xcd - r) * q) + off; }
        const int nig = WGM * nN, gid = wgid / nig, fm = gid * WGM, gsz = (nM - fm) < WGM ? (nM - fm) : WGM;
        u.pm = fm + ((wgid % nig) % gsz); u.pn = (wgid % nig) / gsz; u.e = 0; u.ui = i; return true;
    }
    __device__ __forceinline__ size_t a_off(const Unit& u) const { return (size_t)u.pm * BM * rb; }
    __device__ __forceinline__ size_t b_off(const Unit& u) const { return (size_t)u.pn * BM * rb; }
};
struct GroupedOrder {
    int nM, nN, nwg, G, c, rb; const LAS int* tab; size_t bexp;
    __device__ void init(int nM_, int N, int rb_, int G_, int c_, const LAS int* tab_, size_t bexp_) { nM = nM_; nN = N / BM; nwg = nM * nN; G = G_; c = c_; rb = rb_; tab = tab_; bexp = bexp_; }
    __device__ __forceinline__ bool next(int i, Unit& u) const {
        const long L = (long)i * G + c; if (L >= nwg) return false;
        int wgid = (int)L; { const int q = nwg / NXCD, r = nwg % NXCD, xcd = wgid % NXCD, off = wgid / NXCD; wgid = (xcd < r ? xcd * (q + 1) : r * (q + 1) + (xcd - r) * q) + off; }
        const int nig = WGM * nN, gid = wgid / nig, fm = gid * WGM, gsz = (nM - fm) < WGM ? (nM - fm) : WGM;
        u.pm = fm + ((wgid % nig) % gsz); u.pn = (wgid % nig) / gsz; u.e = __builtin_amdgcn_readfirstlane(tab[u.pm]); u.ui = i; return true;
    }
    __device__ __forceinline__ size_t a_off(const Unit& u) const { return (size_t)u.pm * BM * rb; }
    __device__ __forceinline__ size_t b_off(const Unit& u) const { return (size_t)u.e * bexp + (size_t)u.pn * BM * rb; }
};

struct EpiQKV {
    static constexpr bool PERM = true;
    bf16_t* O; size_t stride; float qscale;
    __device__ __forceinline__ void operator()(const f32x4 (&acc)[2][2][4][2], const Unit& u, int wr, int wc, int fr, int fq) const {
        const int t = u.pn >> 1; bf16_t* base = O + (size_t)t * stride; const float sc = (t == 1) ? qscale : 1.f;
        const int row0 = u.pm * BM + wr * 64 + fr, col0 = (u.pn & 1) * BM + wc * 32 + 8 * fq;
#pragma unroll
        for (int ai = 0; ai < 2; ++ai)
#pragma unroll
            for (int m = 0; m < 4; ++m) { bf16_t* rowp = base + (size_t)(row0 + ai * HALF + m * 16) * 512 + col0;
#pragma unroll
                for (int bj = 0; bj < 2; ++bj) { const f32x4 v0 = acc[ai][bj][m][0] * sc, v1 = acc[ai][bj][m][1] * sc;
                    u32x4 w; w.x = pkbf(v0[0], v0[1]); w.y = pkbf(v0[2], v0[3]); w.z = pkbf(v1[0], v1[1]); w.w = pkbf(v1[2], v1[3]);
                    *(u32x4*)(rowp + bj * HALF) = w; } }
    }
};
struct EpiResF32 {
    static constexpr bool PERM = false;
    const float* base; float* out;
    __device__ __forceinline__ void operator()(const f32x4 (&acc)[2][2][4][2], const Unit& u, int wr, int wc, int fr, int fq) const {
        const int col0 = u.pn * BM + wc * 32 + 4 * fq;
#pragma unroll
        for (int ai = 0; ai < 2; ++ai)
#pragma unroll
            for (int m = 0; m < 4; ++m) { const size_t off = (size_t)(u.pm * BM + ai * HALF + wr * 64 + m * 16 + fr) * 1024 + col0;
#pragma unroll
                for (int bj = 0; bj < 2; ++bj)
#pragma unroll
                    for (int n = 0; n < 2; ++n) { const f32x4 bs = __builtin_nontemporal_load((const f32x4*)(base + off + bj * HALF + n * 16)); *(f32x4*)(out + off + bj * HALF + n * 16) = bs + acc[ai][bj][m][n]; } }
    }
};
struct EpiSwiGLU {
    static constexpr bool PERM = true;
    unsigned char* O; const float* bgu; const LAS float* rs;
    __device__ __forceinline__ void operator()(const f32x4 (&acc)[2][2][4][2], const Unit& u, int wr, int wc, int fr, int fq) const {
        const int row0 = u.pm * BM + wr * 64 + fr, jc0 = wc * 32 + 8 * fq;
        const float* bg = bgu + (size_t)u.e * 2048 + u.pn * 128 + jc0; const float* bl = bg + 1024;
        f32x4 bgv[2], blv[2];
#pragma unroll
        for (int n = 0; n < 2; ++n) { bgv[n] = *(const f32x4*)(bg + 4 * n); blv[n] = *(const f32x4*)(bl + 4 * n); }
        const int odd = fq & 1;
        unsigned char* cbase = O + (size_t)(row0 + odd * 16) * 1024 + u.pn * 128 + wc * 32 + 8 * (fq - odd);
#pragma unroll
        for (int ai = 0; ai < 2; ++ai)
#pragma unroll
            for (int mp = 0; mp < 2; ++mp) {
                u32x2 w2[2];
#pragma unroll
                for (int mm = 0; mm < 2; ++mm) { const int m = 2 * mp + mm;
                    const float rsc = rs[u.ui * 256 + wr * 64 + fr + ai * HALF + m * 16] * (1.0f / (W_SCALE * XS_SCALE));
                    float a[8];
#pragma unroll
                    for (int n = 0; n < 2; ++n) { const f32x4 g4 = acc[ai][0][m][n] * rsc + bgv[n], l4 = acc[ai][1][m][n] * rsc + blv[n];
#pragma unroll
                        for (int j = 0; j < 4; ++j) { const float gate = fminf(g4[j], 7.0f); const float lin = fminf(fmaxf(l4[j], -7.0f), 7.0f);
                            const float sg = __builtin_amdgcn_rcpf(1.0f + __builtin_amdgcn_exp2f(gate * (-1.702f * 1.4426950408889634f)));
                            a[4 * n + j] = gate * sg * (lin + 1.0f) * ACT_SCALE; } }
                    w2[mm].x = pk4f8(a[0], a[1], a[2], a[3]); w2[mm].y = pk4f8(a[4], a[5], a[6], a[7]); }
                const auto sx = __builtin_amdgcn_permlane16_swap(w2[0].x, w2[1].x, false, false), sy = __builtin_amdgcn_permlane16_swap(w2[0].y, w2[1].y, false, false);
                u32x4 o; o.x = sx[0]; o.y = sy[0]; o.z = sx[1]; o.w = sy[1];
                *(u32x4*)(cbase + (size_t)(ai * HALF + mp * 32) * 1024) = o; }
    }
};
struct EpiBiasBf16 {
    static constexpr bool PERM = true;
    unsigned char* O; const float* bias;
    __device__ __forceinline__ void operator()(const f32x4 (&acc)[2][2][4][2], const Unit& u, int wr, int wc, int fr, int fq) const {
        const int row0 = u.pm * BM + wr * 64 + fr, col0 = u.pn * BM + wc * 32 + 8 * fq;
        const float* bp = bias + (size_t)u.e * 1024 + col0;
        f32x4 bv[2][2];
#pragma unroll
        for (int bj = 0; bj < 2; ++bj)
#pragma unroll
            for (int n = 0; n < 2; ++n) bv[bj][n] = *(const f32x4*)(bp + bj * HALF + 4 * n);
        const int odd = fq & 1;
        unsigned char* cbase = O + (size_t)(row0 + odd * 16) * 1024 + u.pn * BM + wc * 32 + 8 * (fq - odd);
#pragma unroll
        for (int ai = 0; ai < 2; ++ai)
#pragma unroll
            for (int mp = 0; mp < 2; ++mp)
#pragma unroll
                for (int bj = 0; bj < 2; ++bj) {
                    u32x2 w2[2];
#pragma unroll
                    for (int mm = 0; mm < 2; ++mm) { const int m = 2 * mp + mm;
                        const f32x4 v0 = (acc[ai][bj][m][0] * (1.0f / (W_SCALE * ACT_SCALE)) + bv[bj][0]) * Y_SCALE, v1 = (acc[ai][bj][m][1] * (1.0f / (W_SCALE * ACT_SCALE)) + bv[bj][1]) * Y_SCALE;
                        w2[mm].x = pk4f8(v0[0], v0[1], v0[2], v0[3]); w2[mm].y = pk4f8(v1[0], v1[1], v1[2], v1[3]); }
                    const auto sx = __builtin_amdgcn_permlane16_swap(w2[0].x, w2[1].x, false, false), sy = __builtin_amdgcn_permlane16_swap(w2[0].y, w2[1].y, false, false);
                    u32x4 o; o.x = sx[0]; o.y = sy[0]; o.z = sx[1]; o.w = sy[1];
                    *(u32x4*)(cbase + (size_t)(ai * HALF + mp * 32) * 1024 + bj * HALF) = o; }
    }
};

template <class Epi, class Sched, bool ALIGN_EPI>
__device__ __forceinline__ void gemm_phase(LAS unsigned char* lds, const Gemm g, const Sched& S, const Epi& E) {
    const int tid = threadIdx.x, wid = __builtin_amdgcn_readfirstlane(tid >> 6), lane = tid & 63, wr = wid >> 2, wc = wid & 3, fr = lane & 15, fq = lane >> 4;
    const int K = g.K, nt = K / BK;
    unsigned voffA, voffB;
    { int R, C; stage_rc(tid * 16, R, C); const int Rb = Epi::PERM ? ((R & ~31) + perm32(R & 31)) : R;
        voffA = (unsigned)(R * K + C) * 2u; voffB = (unsigned)(Rb * K + C) * 2u; }
    const size_t pstep = (size_t)64 * K * 2;
    const size_t kstep = (size_t)(BK * 2);
    const size_t hstep = (size_t)HALF * K * 2;
    const unsigned ldsw = (unsigned)wid * 1024u;
    const int aoff = lds_byte(wr * 64 + fr, fq * 8), boff = lds_byte(wc * 32 + fr, fq * 8);
#define PG8_SA(b, h) (((b) * 2 + (h)) * HTB)
#define PG8_SB(b, h) ((4 + (b) * 2 + (h)) * HTB)
#define PG8_STAGE(bufoff, gbase, voff) do { _Pragma("unroll") for (int _i = 0; _i < 2; ++_i) \
        __builtin_amdgcn_global_load_lds((const unsigned*)((const char*)(gbase) + _i * pstep + (voff)), (LAS unsigned*)(lds + (bufoff) + ldsw + _i * 8192), 16, 0, 0); } while (0)
#define PG8_LDA(dst, b, h) do { _Pragma("unroll") for (int m = 0; m < 4; ++m) _Pragma("unroll") for (int k = 0; k < 2; ++k) dst[m][k] = *(const LAS bf16x8*)(lds + PG8_SA(b, h) + aoff + m * 2048 + k * 1024); } while (0)
#define PG8_LDB(dst, b, h) do { _Pragma("unroll") for (int n = 0; n < 2; ++n) _Pragma("unroll") for (int k = 0; k < 2; ++k) dst[n][k] = *(const LAS bf16x8*)(lds + PG8_SB(b, h) + boff + n * 2048 + k * 1024); } while (0)
#define PG8_MMA(ai, bj, At, Bt) do { __builtin_amdgcn_s_setprio(1); _Pragma("unroll") for (int m = 0; m < 4; ++m) _Pragma("unroll") for (int n = 0; n < 2; ++n) _Pragma("unroll") for (int k = 0; k < 2; ++k) \
        acc[ai][bj][m][n] = __builtin_amdgcn_mfma_f32_16x16x32_bf16(Bt[n][k], At[m][k], acc[ai][bj][m][n], 0, 0, 0); __builtin_amdgcn_s_setprio(0); } while (0)
#define PG8_WAIT_V(n) asm volatile("s_waitcnt vmcnt(" #n ")" ::: "memory")
#define PG8_WAIT_L(n) asm volatile("s_waitcnt lgkmcnt(" #n ")" ::: "memory")
#define PG8_BAR __builtin_amdgcn_s_barrier()
#define PG8_SCHED __builtin_amdgcn_sched_barrier(0)
    Unit cur, nxt; int ui = 0;
    if (!S.next(0, cur)) return;
    f32x4 acc[2][2][4][2];
#pragma unroll
    for (int a = 0; a < 2; ++a)
#pragma unroll
        for (int b = 0; b < 2; ++b)
#pragma unroll
            for (int m = 0; m < 4; ++m)
#pragma unroll
                for (int n = 0; n < 2; ++n) acc[a][b][m][n] = (f32x4){0.f, 0.f, 0.f, 0.f};
    bf16x8 At[4][2], B0[2][2], B1[2][2];
    const char* cA = (const char*)g.A + S.a_off(cur); const char* cB = (const char*)g.Bt + S.b_off(cur);
    PG8_STAGE(PG8_SB(0, 0), cB, voffB); PG8_STAGE(PG8_SB(0, 1), cB + hstep, voffB); PG8_STAGE(PG8_SA(0, 0), cA, voffA); PG8_STAGE(PG8_SA(0, 1), cA + hstep, voffA);
    if (wr == 1) PG8_BAR;
    PG8_WAIT_V(2); PG8_BAR;
    PG8_STAGE(PG8_SB(1, 0), cB + kstep, voffB); PG8_STAGE(PG8_SA(1, 0), cA + kstep, voffA); PG8_STAGE(PG8_SB(1, 1), cB + hstep + kstep, voffB);
    PG8_WAIT_V(6); PG8_BAR;
    for (;;) {
        const bool has_next = S.next(ui + 1, nxt);
        const char* nA = has_next ? (const char*)g.A + S.a_off(nxt) : cA; const char* nB = has_next ? (const char*)g.Bt + S.b_off(nxt) : cB;
#pragma nounroll
        for (int t = 0; t < nt; t += 2) {
            const bool last = (t == nt - 2);
            const char* a1 = cA + (size_t)(t + 1) * kstep;
            const char* a2 = last ? nA : cA + (size_t)(t + 2) * kstep; const char* b2 = last ? nB : cB + (size_t)(t + 2) * kstep;
            const char* a3 = a2 + kstep; const char* b3 = b2 + kstep;
            PG8_LDB(B0, 0, 0); PG8_LDB(B1, 0, 1); PG8_SCHED; PG8_LDA(At, 0, 0); PG8_STAGE(PG8_SA(1, 1), a1 + hstep, voffA);
            PG8_WAIT_V(8); PG8_WAIT_L(0); PG8_BAR; PG8_MMA(0, 0, At, B0); PG8_MMA(0, 1, At, B1); PG8_BAR; PG8_SCHED;
            PG8_LDA(At, 0, 1); PG8_STAGE(PG8_SB(0, 0), b2, voffB); PG8_STAGE(PG8_SB(0, 1), b2 + hstep, voffB); PG8_STAGE(PG8_SA(0, 0), a2, voffA);
            PG8_WAIT_V(8); PG8_WAIT_L(0); PG8_BAR; PG8_MMA(1, 0, At, B0); PG8_MMA(1, 1, At, B1); PG8_BAR; PG8_SCHED;
            PG8_LDB(B0, 1, 0); PG8_LDB(B1, 1, 1); PG8_SCHED; PG8_LDA(At, 1, 0); PG8_STAGE(PG8_SA(0, 1), a2 + hstep, voffA);
            PG8_WAIT_V(8); PG8_WAIT_L(0); PG8_BAR; PG8_MMA(0, 0, At, B0); PG8_MMA(0, 1, At, B1); PG8_BAR; PG8_SCHED;
            PG8_LDA(At, 1, 1); PG8_STAGE(PG8_SB(1, 0), b3, voffB); PG8_STAGE(PG8_SB(1, 1), b3 + hstep, voffB); PG8_STAGE(PG8_SA(1, 0), a3, voffA);
            PG8_WAIT_V(8); PG8_WAIT_L(0); PG8_BAR; PG8_MMA(1, 0, At, B0); PG8_MMA(1, 1, At, B1); PG8_BAR; PG8_SCHED;
        }
        if constexpr (ALIGN_EPI) { if (wr == 0) PG8_BAR; }
        E(acc, cur, wr, wc, fr, fq);
        if (!has_next) break;
#pragma unroll
        for (int a = 0; a < 2; ++a)
#pragma unroll
            for (int b = 0; b < 2; ++b)
#pragma unroll
                for (int m = 0; m < 4; ++m)
#pragma unroll
                    for (int n = 0; n < 2; ++n) acc[a][b][m][n] = (f32x4){0.f, 0.f, 0.f, 0.f};
        cur = nxt; cA = nA; cB = nB; ++ui;
        if constexpr (ALIGN_EPI) { if (wr == 1) PG8_BAR; }
    }
    PG8_WAIT_V(0);
    if constexpr (!ALIGN_EPI) { if (wr == 0) PG8_BAR; }
    PG8_BAR;
#undef PG8_SA
#undef PG8_SB
#undef PG8_STAGE
#undef PG8_LDA
#undef PG8_LDB
#undef PG8_MMA
#undef PG8_WAIT_V
#undef PG8_WAIT_L
#undef PG8_BAR
#undef PG8_SCHED
}
__host__ __device__ __forceinline__ int f8swz(int r) { return ((r >> 2) & 1) | (((r >> 1) & 1) << 2); }
struct Gemm8 { const unsigned char* A; const unsigned char* Bt; int Kb; };
template <class Epi, class Sched, bool ALIGN_EPI, bool GATHER = false>
__device__ __forceinline__ void gemm_phase_f8(LAS unsigned char* lds, const Gemm8 g, const Sched& S, const Epi& E, const LAS int* rowtab = nullptr) {
    const int tid = threadIdx.x, wid = __builtin_amdgcn_readfirstlane(tid >> 6), lane = tid & 63, wr = wid >> 2, wc = wid & 3, fr = lane & 15, fq = lane >> 4;
    const int Kb = g.Kb, nt = Kb / 128;
    unsigned voffA, voffB;
    { const int b = tid * 16, R = b >> 7, c = ((b >> 4) & 7) ^ f8swz(R & 15); const int Rb = Epi::PERM ? ((R & ~31) + perm32(R & 31)) : R;
        voffA = (unsigned)(R * Kb + 16 * c); voffB = (unsigned)(Rb * Kb + 16 * c); }
    const size_t pstep = (size_t)64 * Kb;
    const size_t kstep = 128;
    const int gc16 = 16 * ((tid & 7) ^ f8swz((tid >> 3) & 15));
    unsigned offC[2][2], offN[2][2];
#define PG8_ROWOFF(dst, uidx) do { _Pragma("unroll") for (int _h = 0; _h < 2; ++_h) _Pragma("unroll") for (int _i = 0; _i < 2; ++_i) dst[_h][_i] = (unsigned)(rowtab[(uidx) * 256 + _h * 128 + _i * 64 + (tid >> 3)] + gc16); } while (0)
#define PG8_STAGE_G(bufoff, kbyte, offs, h) do { _Pragma("unroll") for (int _i = 0; _i < 2; ++_i) \
        __builtin_amdgcn_global_load_lds((const unsigned*)((const char*)g.A + (kbyte) + (offs)[h][_i]), (LAS unsigned*)(lds + (bufoff) + ldsw + _i * 8192), 16, 0, 0); } while (0)
#define PG8_STAGE_A(b, h, ptr, kbyte, offs) do { if constexpr (GATHER) PG8_STAGE_G(PG8_SA(b, h), kbyte, offs, h); else PG8_STAGE(PG8_SA(b, h), (ptr) + (h) * hstep, voffA); } while (0)
    const size_t hstep = (size_t)HALF * Kb;
    const unsigned ldsw = (unsigned)wid * 1024u;
    LAS unsigned char* ab0 = lds + 128 * (wr * 64 + fr) + 16 * ((2 * fq) ^ f8swz(fr)); LAS unsigned char* ab1 = lds + 128 * (wr * 64 + fr) + 16 * ((2 * fq + 1) ^ f8swz(fr));
    LAS unsigned char* bb0 = lds + 65536 + 128 * (wc * 32 + fr) + 16 * ((2 * fq) ^ f8swz(fr)); LAS unsigned char* bb1 = lds + 65536 + 128 * (wc * 32 + fr) + 16 * ((2 * fq + 1) ^ f8swz(fr));
    asm volatile("" : "+v"(ab0), "+v"(ab1), "+v"(bb0), "+v"(bb1));
#define PG8_SA(b, h) (((b) * 2 + (h)) * HTB)
#define PG8_SB(b, h) ((4 + (b) * 2 + (h)) * HTB)
#define PG8_STAGE(bufoff, gbase, voff) do { _Pragma("unroll") for (int _i = 0; _i < 2; ++_i) \
        __builtin_amdgcn_global_load_lds((const unsigned*)((const char*)(gbase) + _i * pstep + (voff)), (LAS unsigned*)(lds + (bufoff) + ldsw + _i * 8192), 16, 0, 0); } while (0)
#define PG8_LDA(dst, b, h) do { _Pragma("unroll") for (int m = 0; m < 4; ++m) { dst[m][0] = *(const LAS u32x4*)(ab0 + PG8_SA(b, h) + m * 2048); dst[m][1] = *(const LAS u32x4*)(ab1 + PG8_SA(b, h) + m * 2048); } } while (0)
#define PG8_LDB(dst, b, h) do { _Pragma("unroll") for (int n = 0; n < 2; ++n) { dst[n][0] = *(const LAS u32x4*)(bb0 + PG8_SA(b, h) + n * 2048); dst[n][1] = *(const LAS u32x4*)(bb1 + PG8_SA(b, h) + n * 2048); } } while (0)
#define PG8_CAT(x) __builtin_bit_cast(v8i32, __builtin_shufflevector((x)[0], (x)[1], 0, 1, 2, 3, 4, 5, 6, 7))
#define PG8_MMA(ai, bj, At, Bt) do { __builtin_amdgcn_s_setprio(1); _Pragma("unroll") for (int m = 0; m < 4; ++m) _Pragma("unroll") for (int n = 0; n < 2; ++n) \
        asm volatile("v_mfma_f32_16x16x128_f8f6f4 %0, %1, %2, %0" : "+v"(acc[ai][bj][m][n]) : "v"(PG8_CAT(Bt[n])), "v"(PG8_CAT(At[m]))); __builtin_amdgcn_s_setprio(0); } while (0)
#define PG8_WAIT_V(n) asm volatile("s_waitcnt vmcnt(" #n ")" ::: "memory")
#define PG8_WAIT_L(n) asm volatile("s_waitcnt lgkmcnt(" #n ")" ::: "memory")
#define PG8_BAR __builtin_amdgcn_s_barrier()
#define PG8_SCHED __builtin_amdgcn_sched_barrier(0)
    Unit cur, nxt; int ui = 0;
    if (!S.next(0, cur)) return;
    f32x4 acc[2][2][4][2];
#pragma unroll
    for (int a = 0; a < 2; ++a)
#pragma unroll
        for (int b = 0; b < 2; ++b)
#pragma unroll
            for (int m = 0; m < 4; ++m)
#pragma unroll
                for (int n = 0; n < 2; ++n) acc[a][b][m][n] = (f32x4){0.f, 0.f, 0.f, 0.f};
    u32x4 At[4][2], B0[2][2], B1[2][2];
    const char* cA = (const char*)g.A + (GATHER ? 0 : S.a_off(cur)); const char* cB = (const char*)g.Bt + S.b_off(cur);
    if constexpr (GATHER) { PG8_ROWOFF(offC, 0); }
    PG8_STAGE(PG8_SB(0, 0), cB, voffB); PG8_STAGE(PG8_SB(0, 1), cB + hstep, voffB); PG8_STAGE_A(0, 0, cA, 0, offC); PG8_STAGE_A(0, 1, cA, 0, offC);
    if (wr == 1) PG8_BAR;
    PG8_WAIT_V(2); PG8_BAR;
    PG8_STAGE(PG8_SB(1, 0), cB + kstep, voffB); PG8_STAGE_A(1, 0, cA + kstep, 128, offC); PG8_STAGE(PG8_SB(1, 1), cB + hstep + kstep, voffB);
    PG8_WAIT_V(6); PG8_BAR;
    for (;;) {
        const bool has_next = S.next(ui + 1, nxt);
        const char* nA = (has_next && !GATHER) ? (const char*)g.A + S.a_off(nxt) : cA; const char* nB = has_next ? (const char*)g.Bt + S.b_off(nxt) : cB;
        if constexpr (GATHER) { if (has_next) { PG8_ROWOFF(offN, ui + 1); } else {
#pragma unroll
            for (int _h = 0; _h < 2; ++_h)
#pragma unroll
                for (int _i = 0; _i < 2; ++_i) offN[_h][_i] = offC[_h][_i]; } }
#pragma nounroll
        for (int t = 0; t < nt; t += 2) {
            const bool last = (t == nt - 2);
            const char* a1 = cA + (size_t)(t + 1) * kstep;
            const char* a2 = last ? nA : cA + (size_t)(t + 2) * kstep; const char* b2 = last ? nB : cB + (size_t)(t + 2) * kstep;
            const char* a3 = a2 + kstep; const char* b3 = b2 + kstep;
            const int kb1 = (t + 1) * 128, kb2 = last ? 0 : (t + 2) * 128, kb3 = kb2 + 128;
            unsigned off2[2][2];
            if constexpr (GATHER) {
#pragma unroll
                for (int _h = 0; _h < 2; ++_h)
#pragma unroll
                    for (int _i = 0; _i < 2; ++_i) off2[_h][_i] = last ? offN[_h][_i] : offC[_h][_i]; }
            PG8_LDB(B0, 0, 0); PG8_LDB(B1, 0, 1); PG8_SCHED; PG8_LDA(At, 0, 0); PG8_STAGE_A(1, 1, a1, kb1, offC);
            PG8_WAIT_V(8); PG8_WAIT_L(0); PG8_BAR; PG8_MMA(0, 0, At, B0); PG8_MMA(0, 1, At, B1); PG8_BAR; PG8_SCHED;
            PG8_LDA(At, 0, 1); PG8_STAGE(PG8_SB(0, 0), b2, voffB); PG8_STAGE(PG8_SB(0, 1), b2 + hstep, voffB); PG8_STAGE_A(0, 0, a2, kb2, off2);
            PG8_WAIT_V(8); PG8_WAIT_L(0); PG8_BAR; PG8_MMA(1, 0, At, B0); PG8_MMA(1, 1, At, B1); PG8_BAR; PG8_SCHED;
            PG8_LDB(B0, 1, 0); PG8_LDB(B1, 1, 1); PG8_SCHED; PG8_LDA(At, 1, 0); PG8_STAGE_A(0, 1, a2, kb2, off2);
            PG8_WAIT_V(8); PG8_WAIT_L(0); PG8_BAR; PG8_MMA(0, 0, At, B0); PG8_MMA(0, 1, At, B1); PG8_BAR; PG8_SCHED;
            PG8_LDA(At, 1, 1); PG8_STAGE(PG8_SB(1, 0), b3, voffB); PG8_STAGE(PG8_SB(1, 1), b3 + hstep, voffB); PG8_STAGE_A(1, 0, a3, kb3, off2);
            PG8_WAIT_V(8); PG8_WAIT_L(0); PG8_BAR; PG8_MMA(1, 0, At, B0); PG8_MMA(1, 1, At, B1); PG8_BAR; PG8_SCHED;
        }
        if constexpr (ALIGN_EPI) { if (wr == 0) PG8_BAR; }
        asm volatile("s_nop 15\n\ts_nop 7" ::: "memory");
        E(acc, cur, wr, wc, fr, fq);
        if (!has_next) break;
#pragma unroll
        for (int a = 0; a < 2; ++a)
#pragma unroll
            for (int b = 0; b < 2; ++b)
#pragma unroll
                for (int m = 0; m < 4; ++m)
#pragma unroll
                    for (int n = 0; n < 2; ++n) acc[a][b][m][n] = (f32x4){0.f, 0.f, 0.f, 0.f};
        cur = nxt; cA = nA; cB = nB; ++ui;
        if constexpr (GATHER) {
#pragma unroll
            for (int _h = 0; _h < 2; ++_h)
#pragma unroll
                for (int _i = 0; _i < 2; ++_i) offC[_h][_i] = offN[_h][_i]; }
        if constexpr (ALIGN_EPI) { if (wr == 1) PG8_BAR; }
    }
    PG8_WAIT_V(0);
    if constexpr (!ALIGN_EPI) { if (wr == 0) PG8_BAR; }
    PG8_BAR;
#undef PG8_ROWOFF
#undef PG8_STAGE_G
#undef PG8_STAGE_A
#undef PG8_SA
#undef PG8_SB
#undef PG8_STAGE
#undef PG8_LDA
#undef PG8_LDB
#undef PG8_CAT
#undef PG8_MMA
#undef PG8_WAIT_V
#undef PG8_WAIT_L
#undef PG8_BAR
#undef PG8_SCHED
}
}

constexpr size_t MiB = 1u << 20;
constexpr size_t WS_CTL = 0, CTL_ZERO_BYTES = 1 * MiB;
constexpr size_t WS_WIN = 1 * MiB, WS_WO = 5 * MiB;
constexpr size_t WS_TAB = 7 * MiB;
constexpr size_t WS_TOPI = 8 * MiB, WS_GATE = WS_TOPI + 256 * 1024, WS_LRANK = WS_GATE + 256 * 1024, WS_POS = WS_LRANK + 256 * 1024;
constexpr size_t WS_RSTD = 12 * MiB, WS_INV = 13 * MiB;
constexpr int CW_CNT = 256;
constexpr size_t WS_ML = 9 * MiB;
constexpr size_t WS_WGU = 16 * MiB, WS_WD = 144 * MiB, WS_XN = 208 * MiB;
constexpr size_t WS_U = 240 * MiB, WS_Q = 256 * MiB, WS_K = 272 * MiB, WS_V = 288 * MiB;
constexpr size_t WS_OB = 304 * MiB, WS_MIX = 352 * MiB, WS_XMID = 384 * MiB, WS_XS = 448 * MiB, WS_ACT = 592 * MiB, WS_Y = 736 * MiB, WS_END = 880 * MiB;
constexpr int CW_BAR = 4096;

constexpr int RING_BYTES = 131072, LDSCTL_OFF = RING_BYTES, MISC_OFF = LDSCTL_OFF + 320;
constexpr int LDS_NMT_OFF = LDSCTL_OFF + 512, LDS_TAB_OFF = LDSCTL_OFF + 1024, LDS_TOPI_OFF = LDSCTL_OFF + 4096, LDS_P6_OFF = LDSCTL_OFF + 8192, LDS_G_OFF = LDSCTL_OFF + 8192, LDS_ROWT_OFF = LDSCTL_OFF + 12288;
constexpr int MAX_UNITS = 10;
constexpr int LDS_RSTB_OFF = LDS_ROWT_OFF + MAX_UNITS * 1024;
constexpr int LDS_BYTES = 163840;

#define XB_TMO      128
#define XB_XCNT(j)  (256  + 64 * (j))
#define XB_XSUB(j)  (1280 + 64 * (j))
#define XB_XGEN(j)  (2304 + 64 * (j))
#define XB_TOP      3328
#define XB_TOPGEN   3392
#define XCD_BAR_WORDS 3456
#define XB_SPIN_CAP (1u << 18)
__device__ __forceinline__ unsigned xb_ld(unsigned* p)              { return __hip_atomic_load(p, __ATOMIC_RELAXED, __HIP_MEMORY_SCOPE_AGENT); }
__device__ __forceinline__ unsigned xb_add(unsigned* p, unsigned v) { return __hip_atomic_fetch_add(p, v, __ATOMIC_RELAXED, __HIP_MEMORY_SCOPE_AGENT); }
__device__ __forceinline__ unsigned xb_xcc_id() { return (unsigned)__builtin_amdgcn_s_getreg((3 << 11) | 20) & 0xFu; }
#define XB_SPIN(cond, bar) do { unsigned _sp = 0; while (cond) { __builtin_amdgcn_s_sleep(1); \
    if ((++_sp & 255u) == 0u) { if (xb_ld(&(bar)[XB_TMO])) break; if (_sp > XB_SPIN_CAP) { atomicAdd(&(bar)[XB_TMO], 1u); break; } } } } while (0)
struct XcdBarrier { unsigned* bar; unsigned x; volatile LAS unsigned* st; };
__device__ __forceinline__ XcdBarrier xcd_barrier_post(unsigned* bar, volatile LAS unsigned* st) {
    XcdBarrier b; b.bar = bar; b.x = xb_xcc_id(); b.st = st;
    if (threadIdx.x == 0) (void)xb_add(&bar[XB_XCNT(b.x)], 1u);
    return b;
}
__device__ __forceinline__ void xcd_barrier_complete(unsigned* bar, unsigned x, unsigned& nloc, unsigned& nx) {
    const unsigned G = gridDim.x * gridDim.y * gridDim.z;
    unsigned sum, cnt, mine, sp = 0u;
    for (;;) {
        sum = 0u; cnt = 0u; mine = 0u;
#pragma unroll
        for (unsigned j = 0; j < 16; ++j) { const unsigned c = xb_ld(&bar[XB_XCNT(j)]); sum += c; cnt += (c > 0u) ? 1u : 0u; mine = (j == x) ? c : mine; }
        if (sum == G) break;
        __builtin_amdgcn_s_sleep(1);
        if ((++sp & 255u) == 0u) { if (xb_ld(&bar[XB_TMO])) break; if (sp > XB_SPIN_CAP) { atomicAdd(&bar[XB_TMO], 1u); break; } }
    }
    nloc = mine > 0u ? mine : 1u; nx = cnt > 0u ? cnt : 1u;
}
__device__ __forceinline__ void xcd_barrier(const XcdBarrier& b) {
    asm volatile("s_waitcnt vmcnt(0)" ::: "memory");
    __syncthreads();
    if (threadIdx.x == 0) {
        unsigned* bar = b.bar;
        __builtin_amdgcn_s_waitcnt(0);
        unsigned nloc = b.st[0], nx = b.st[1];
        if (nloc == 0u) { xcd_barrier_complete(bar, b.x, nloc, nx); b.st[0] = nloc; b.st[1] = nx; }
        const unsigned old = xb_add(&bar[XB_XSUB(b.x)], 1u);
        const unsigned gen = old / nloc;
        if (old + 1u == (gen + 1u) * nloc) {
            __builtin_amdgcn_fence(__ATOMIC_RELEASE, "agent");
            asm volatile("s_waitcnt vmcnt(0)" ::: "memory");
            const unsigned og = xb_add(&bar[XB_TOP], 1u);
            const unsigned tg = og / nx;
            if (og + 1u == (tg + 1u) * nx) xb_add(&bar[XB_TOPGEN], 1u);
            else XB_SPIN(xb_ld(&bar[XB_TOPGEN]) == tg, bar);
            __builtin_amdgcn_fence(__ATOMIC_ACQUIRE, "agent");
            xb_add(&bar[XB_XGEN(b.x)], 1u);
            asm volatile("s_waitcnt vmcnt(0)" ::: "memory");
        } else {
            XB_SPIN(xb_ld(&bar[XB_XGEN(b.x)]) == gen, bar);
            __builtin_amdgcn_fence(__ATOMIC_ACQUIRE, "agent");
            asm volatile("s_waitcnt vmcnt(0)" ::: "memory");
        }
    }
    __syncthreads();
}

__device__ __forceinline__ float wave_sum(float v) {
#pragma unroll
    for (int o = 1; o < 64; o <<= 1) v += __shfl_xor(v, o);
    return v;
}
__device__ __forceinline__ void rms_row_to_bf16(const float* xrow, const float* g, bf16_t* orow, int lane) {
    const f32x4* xr = (const f32x4*)xrow + lane; const f32x4* gr = (const f32x4*)g + lane;
    f32x4 v[4]; float s = 0.f;
#pragma unroll
    for (int j = 0; j < 4; ++j) { v[j] = __builtin_nontemporal_load(xr + 64 * j); s += (v[j].x * v[j].x + v[j].y * v[j].y) + (v[j].z * v[j].z + v[j].w * v[j].w); }
    const float rstd = 1.0f / sqrtf(wave_sum(s) * (1.f / D) + EPS);
    u32x2* o8 = (u32x2*)orow + lane;
#pragma unroll
    for (int j = 0; j < 4; ++j) { const f32x4 gv = gr[64 * j]; u32x2 w; w.x = pkbf(v[j].x * rstd * gv.x, v[j].y * rstd * gv.y); w.y = pkbf(v[j].z * rstd * gv.z, v[j].w * rstd * gv.w); o8[64 * j] = w; }
}
__device__ __forceinline__ void transpose64(const float* W, int ldn, bf16_t* WT, int ldk, int k0, int n0, int drow0, int dcol0, LAS unsigned char* scr, int lane) {
    const int nc = lane & 15, kq = lane >> 4;
    const float* src = W + (size_t)(k0 + 16 * kq) * ldn + n0 + 4 * nc;
    f32x4 v[16];
#pragma unroll
    for (int it = 0; it < 16; ++it) v[it] = *(const f32x4*)(src + (size_t)it * ldn);
    const int x = nc & 7;
#pragma unroll
    for (int c = 0; c < 4; ++c) { const int n = 4 * nc + c;
        u32x4 lo, hi;
        lo.x = pkbf(v[0][c], v[1][c]); lo.y = pkbf(v[2][c], v[3][c]); lo.z = pkbf(v[4][c], v[5][c]); lo.w = pkbf(v[6][c], v[7][c]);
        hi.x = pkbf(v[8][c], v[9][c]); hi.y = pkbf(v[10][c], v[11][c]); hi.z = pkbf(v[12][c], v[13][c]); hi.w = pkbf(v[14][c], v[15][c]);
        *(LAS u32x4*)(scr + 128 * n + 16 * ((2 * kq) ^ x)) = lo;
        *(LAS u32x4*)(scr + 128 * n + 16 * ((2 * kq + 1) ^ x)) = hi; }
#pragma unroll
    for (int j = 0; j < 8; ++j) { const int n = (lane >> 3) + 8 * j, c = lane & 7, xx = (n >> 2) & 7;
        const u32x4 o = *(const LAS u32x4*)(scr + 128 * n + 16 * (c ^ xx));
        *(u32x4*)(WT + (size_t)(drow0 + n) * ldk + dcol0 + 8 * c) = o; }
}
__device__ __forceinline__ void weff_item(const float* w_pool, const float* pool_scale, const float* w_out, bf16_t* WoT, int item, LAS float* scr, int lane) {
    const int nb = item & 15, cb = (item >> 4) & 15, g = item >> 8;
#pragma unroll
    for (int q = 0; q < 16; ++q) { const int idx = lane + 64 * q, i = idx >> 7, dp = idx & 127; scr[idx] = w_pool[(size_t)(g * 128 + 8 * cb + i) * 128 + dp] * pool_scale[g * 128 + dp]; }
    float acc[8];
#pragma unroll
    for (int i = 0; i < 8; ++i) acc[i] = 0.f;
    const float* wo = w_out + (size_t)(g * 128) * 1024 + nb * 64 + lane;
    for (int dp = 0; dp < 128; dp += 4) {
        const float w0 = wo[(size_t)(dp + 0) * 1024], w1 = wo[(size_t)(dp + 1) * 1024], w2 = wo[(size_t)(dp + 2) * 1024], w3 = wo[(size_t)(dp + 3) * 1024];
#pragma unroll
        for (int i = 0; i < 8; ++i) { const f32x4 s = *(const LAS f32x4*)(scr + i * 128 + dp); acc[i] += (s.x * w0 + s.y * w1) + (s.z * w2 + s.w * w3); }
    }
    u32x4 o; o.x = pkbf(acc[0], acc[1]); o.y = pkbf(acc[2], acc[3]); o.z = pkbf(acc[4], acc[5]); o.w = pkbf(acc[6], acc[7]);
    *(u32x4*)(WoT + (size_t)(nb * 64 + lane) * 1024 + g * 128 + 8 * cb) = o;
}

constexpr int I_GU = 32 * 8 * 32, I_DN = 32 * 8 * 16, N_WITEMS = I_GU + I_DN;
struct WItem { const float* src; unsigned char* dst; int ldn; };
__device__ __forceinline__ WItem witem_decode(int r, const float* w_gu, const float* w_down, unsigned char* WguT, unsigned char* WdT) {
    WItem w;
    if (r < I_GU) { const int e = r >> 8, kb = (r >> 5) & 7, nb = r & 31, n0 = 64 * nb;
        const int drow = (n0 < 1024) ? ((n0 >> 7) * 256 + (n0 & 127)) : (((n0 - 1024) >> 7) * 256 + 128 + ((n0 - 1024) & 127));
        w.src = w_gu + (size_t)e * 1024 * 2048 + (size_t)(128 * kb) * 2048 + n0; w.dst = WguT + (size_t)e * 2048 * 1024 + (size_t)drow * 1024 + 128 * kb; w.ldn = 2048; }
    else { r -= I_GU; const int e = r >> 7, kb = (r >> 4) & 7, nb = r & 15;
        w.src = w_down + (size_t)e * 1024 * 1024 + (size_t)(128 * kb) * 1024 + 64 * nb; w.dst = WdT + (size_t)e * 1024 * 1024 + (size_t)(64 * nb) * 1024 + 128 * kb; w.ldn = 1024; }
    return w;
}
__device__ __forceinline__ void witem_issue(const WItem& w, int half, f32x4 (&v)[16], int lane) {
    const int nc = lane & 15, kq = lane >> 4;
    const float* src = w.src + (size_t)(32 * kq + 16 * half) * w.ldn + 4 * nc;
#pragma unroll
    for (int it = 0; it < 16; ++it) v[it] = __builtin_nontemporal_load((const f32x4*)(src + (size_t)it * w.ldn));
}
__device__ __forceinline__ void witem_finish(const WItem& w, int half, const f32x4 (&v)[16], LAS unsigned char* scr, int lane) {
    const int nc = lane & 15, kq = lane >> 4, x = nc & 7;
#pragma unroll
    for (int c = 0; c < 4; ++c) { const int n = 4 * nc + c;
        u32x4 q; q.x = pk4f8(v[0][c] * W_SCALE, v[1][c] * W_SCALE, v[2][c] * W_SCALE, v[3][c] * W_SCALE); q.y = pk4f8(v[4][c] * W_SCALE, v[5][c] * W_SCALE, v[6][c] * W_SCALE, v[7][c] * W_SCALE);
        q.z = pk4f8(v[8][c] * W_SCALE, v[9][c] * W_SCALE, v[10][c] * W_SCALE, v[11][c] * W_SCALE); q.w = pk4f8(v[12][c] * W_SCALE, v[13][c] * W_SCALE, v[14][c] * W_SCALE, v[15][c] * W_SCALE);
        *(LAS u32x4*)(scr + 128 * n + 16 * ((2 * kq + half) ^ x)) = q; }
    if (half == 1) {
#pragma unroll
        for (int j = 0; j < 8; ++j) { const int n = (lane >> 3) + 8 * j, c = lane & 7, xx = (n >> 2) & 7;
            const u32x4 o = *(const LAS u32x4*)(scr + 128 * n + 16 * (c ^ xx));
            __builtin_nontemporal_store(o, (u32x4*)(w.dst + (size_t)n * 1024 + 16 * c)); }
    }
}

struct AttU { int b, h, br, dil, r, n; };
__device__ __forceinline__ AttU att_decode(int u) {
    u = u % 3072; AttU a; const int bh = u / 48, sub = u % 48; a.b = bh >> 3; a.h = bh & 7; a.br = sub >> 4; const int j = sub & 15;
    if (a.br == 0) { a.dil = 1; a.r = 0; a.n = j; } else if (a.br == 1) { a.dil = 4; a.r = j >> 2; a.n = j & 3; } else { a.dil = 16; a.r = j; a.n = 0; }
    return a;
}
__device__ __forceinline__ void attn_phase(LAS unsigned char* lds, const bf16_t* Qb, const bf16_t* Kb, const bf16_t* Vb, bf16_t* OB, float* ML, int vcu, int G, int tid,
                                           const float* w_gu, const float* w_down, unsigned char* WguT, unsigned char* WdT) {
    constexpr int NU = 64 * 48 * DUPN(2);
    const int lane = tid & 63, wid = rfl(tid >> 6), i16 = lane & 15, fq = lane >> 4;
    const int gwv = vcu * 8 + wid, NGWv = G * 8;
    LAS unsigned char* wscr = lds + 65536 + wid * 8192;
    f32x4 wv[16]; WItem wi; wi.src = nullptr; wi.dst = nullptr; wi.ldn = 0;
    int step = 0;
    u32x4 kreg[4], vreg[4], qreg[2];
    int u = vcu;
    if (u < NU) { const AttU a = att_decode(u);
#pragma unroll
        for (int p = 0; p < 4; ++p) { const int q = tid + 512 * p, row = q >> 3, c = q & 7; int cp = (a.n - 1) * 128 + row; cp = cp < 0 ? 0 : cp;
            const size_t off = (size_t)(a.b * SEQ + cp * a.dil + a.r) * 512 + a.h * 64 + c * 8; kreg[p] = *(const u32x4*)(Kb + off); vreg[p] = *(const u32x4*)(Vb + off); }
        const bf16_t* qp = Qb + (size_t)(a.b * SEQ + (a.n * 128 + 16 * wid + i16) * a.dil + a.r) * 512 + a.h * 64 + 8 * fq;
        qreg[0] = *(const u32x4*)(qp); qreg[1] = *(const u32x4*)(qp + 32); }
    bool wact = (u < NU) && (gwv < N_WITEMS);
    if (wact) { wi = witem_decode(gwv, w_gu, w_down, WguT, WdT); witem_issue(wi, 0, wv, lane); }
    for (; u < NU; u += G, ++step) {
        const AttU a = att_decode(u);
#pragma unroll
        for (int p = 0; p < 4; ++p) { const int q = tid + 512 * p, row = q >> 3, c = q & 7;
            *(LAS u32x4*)(lds + 128 * row + 16 * (c ^ ((row >> 1) & 7))) = kreg[p];
            *(LAS u32x4*)(lds + 32768 + 128 * row + 32 * ((c >> 1) ^ ((row >> 1) & 3)) + 16 * (c & 1)) = vreg[p]; }
        const bf16x8 qf0 = __builtin_bit_cast(bf16x8, qreg[0]), qf1 = __builtin_bit_cast(bf16x8, qreg[1]);
        __syncthreads();
        const int un = u + G;
        if (un < NU) { const AttU a2 = att_decode(un);
#pragma unroll
            for (int p = 0; p < 4; ++p) { const int q = tid + 512 * p, row = q >> 3, c = q & 7; int cp = (a2.n - 1) * 128 + row; cp = cp < 0 ? 0 : cp;
                const size_t off = (size_t)(a2.b * SEQ + cp * a2.dil + a2.r) * 512 + a2.h * 64 + c * 8; kreg[p] = *(const u32x4*)(Kb + off); vreg[p] = *(const u32x4*)(Vb + off); }
            const bf16_t* qp = Qb + (size_t)(a2.b * SEQ + (a2.n * 128 + 16 * wid + i16) * a2.dil + a2.r) * 512 + a2.h * 64 + 8 * fq;
            qreg[0] = *(const u32x4*)(qp); qreg[1] = *(const u32x4*)(qp + 32); }
        asm volatile("" ::: "memory");
        const int qi = 16 * wid + i16;
        const size_t tokq = (size_t)(a.b * SEQ + (a.n * 128 + qi) * a.dil + a.r);
        f32x4 sc[9];
#pragma unroll
        for (int kt = 0; kt < 9; ++kt) { const int row = 16 * (wid + kt) + i16, xr = (row >> 1) & 7;
            const bf16x8 a0 = *(const LAS bf16x8*)(lds + 128 * row + 16 * (fq ^ xr)), a1 = *(const LAS bf16x8*)(lds + 128 * row + 16 * ((4 + fq) ^ xr));
            f32x4 z = (f32x4){0.f, 0.f, 0.f, 0.f};
            z = __builtin_amdgcn_mfma_f32_16x16x32_bf16(a0, qf0, z, 0, 0, 0);
            sc[kt] = __builtin_amdgcn_mfma_f32_16x16x32_bf16(a1, qf1, z, 0, 0, 0); }
        float mx = -1e30f;
#pragma unroll
        for (int kt = 0; kt < 9; ++kt)
#pragma unroll
            for (int j = 0; j < 4; ++j) { bool valid = true; if (kt == 0) valid = (i16 <= 4 * fq + j); if (kt == 8) valid = (4 * fq + j <= i16);
                if (a.n == 0 && wid + kt < 8) valid = false;
                const float s = valid ? sc[kt][j] : -1e30f; sc[kt][j] = s; mx = fmaxf(mx, s); }
        mx = fmaxf(mx, __shfl_xor(mx, 16)); mx = fmaxf(mx, __shfl_xor(mx, 32));
        float l = 0.f;
#pragma unroll
        for (int kt = 0; kt < 9; ++kt)
#pragma unroll
            for (int j = 0; j < 4; ++j) { const float p = __builtin_amdgcn_exp2f(sc[kt][j] - mx); sc[kt][j] = p; l += p; }
        l += __shfl_xor(l, 16); l += __shfl_xor(l, 32);
        f32x4 o[4];
#pragma unroll
        for (int dt = 0; dt < 4; ++dt) o[dt] = (f32x4){0.f, 0.f, 0.f, 0.f};
        const int qq = i16 >> 2, pp = i16 & 3;
#pragma unroll
        for (int sl = 0; sl < 5; ++sl) {
            const int row0 = 16 * (wid + 2 * sl) + 4 * fq + qq, row1 = (sl == 4) ? row0 : row0 + 16;
            u32x4 pw; pw.x = pkbf(sc[2 * sl][0], sc[2 * sl][1]); pw.y = pkbf(sc[2 * sl][2], sc[2 * sl][3]);
            if (sl < 4) { pw.z = pkbf(sc[(2 * sl + 1) % 9][0], sc[(2 * sl + 1) % 9][1]); pw.w = pkbf(sc[(2 * sl + 1) % 9][2], sc[(2 * sl + 1) % 9][3]); } else { pw.z = 0u; pw.w = 0u; }
            const bf16x8 pf = __builtin_bit_cast(bf16x8, pw);
#pragma unroll
            for (int dt = 0; dt < 4; ++dt) {
                const v4i16_t t0 = __builtin_amdgcn_ds_read_tr16_b64_v4i16((LAS v4i16_t*)(lds + 32768 + 128 * row0 + 32 * (dt ^ ((row0 >> 1) & 3)) + 8 * pp));
                const v4i16_t t1 = __builtin_amdgcn_ds_read_tr16_b64_v4i16((LAS v4i16_t*)(lds + 32768 + 128 * row1 + 32 * (dt ^ ((row1 >> 1) & 3)) + 8 * pp));
                const bf16x8 af = (bf16x8){t0[0], t0[1], t0[2], t0[3], t1[0], t1[1], t1[2], t1[3]};
                o[dt] = __builtin_amdgcn_mfma_f32_16x16x32_bf16(af, pf, o[dt], 0, 0, 0);
            }
        }
        const float inv = 1.0f / l;
        bf16_t* op = OB + ((size_t)a.br * T + tokq) * 512 + a.h * 64 + 4 * fq;
#pragma unroll
        for (int dt = 0; dt < 4; ++dt) { u32x2 w; w.x = pkbf(o[dt][0] * inv, o[dt][1] * inv); w.y = pkbf(o[dt][2] * inv, o[dt][3] * inv); *(u32x2*)(op + 16 * dt) = w; }
        if (fq == 0) { f32x2 ml; ml.x = mx; ml.y = l; *(f32x2*)(ML + (((size_t)a.br * T + tokq) * 8 + a.h) * 2) = ml; }
        if (wact) witem_finish(wi, step & 1, wv, wscr, lane);
        {
            const int ns = step + 1, nitem = gwv + (ns >> 1) * NGWv; const bool nact = (u + G < NU) && (nitem < N_WITEMS);
            if (nact) { if ((ns & 1) == 0) wi = witem_decode(nitem, w_gu, w_down, WguT, WdT); witem_issue(wi, ns & 1, wv, lane); }
            wact = nact;
        }
        __syncthreads();
    }
    if (step & 1) { const int witem = gwv + (step >> 1) * NGWv; if (witem < N_WITEMS) { witem_issue(wi, 1, wv, lane); witem_finish(wi, 1, wv, wscr, lane); } ++step; }
    for (int witem = gwv + (step >> 1) * NGWv; witem < N_WITEMS; witem += NGWv) { wi = witem_decode(witem, w_gu, w_down, WguT, WdT);
        witem_issue(wi, 0, wv, lane); witem_finish(wi, 0, wv, wscr, lane); witem_issue(wi, 1, wv, lane); witem_finish(wi, 1, wv, wscr, lane); }
}

struct Args { const float* in[14]; float* out; unsigned char* ws; };
constexpr int NWAVES = 8;

__global__ void __launch_bounds__(NWAVES * 64, 2) mega_fwd(Args args) {
    extern __shared__ __attribute__((aligned(16))) unsigned char lds_raw[];
    LAS unsigned char* lds = (LAS unsigned char*)lds_raw;
    volatile LAS unsigned* MISC = (volatile LAS unsigned*)(lds + MISC_OFF);
    const int tid = threadIdx.x, lane = tid & 63, wave = rfl(tid >> 6);
    const int G = gridDim.x; const int bx = blockIdx.x; const int vcu = (G % 8 == 0) ? (bx % 8) * (G / 8) + bx / 8 : bx;
    unsigned char* ws = args.ws;
    const float* x = args.in[0]; const float* g_mix = args.in[1]; const float* w_in = args.in[2]; const float* w_pool = args.in[3]; const float* pool_scale = args.in[4];
    const float* w_out = args.in[5]; const float* g_ffn = args.in[6]; const float* w_router = args.in[7]; const float* b_router = args.in[8];
    const float* w_gu = args.in[9]; const float* b_gu = args.in[10]; const float* w_down = args.in[11]; const float* b_down = args.in[12]; const float* g_final = args.in[13];
    float* out = args.out;
    bf16_t* WinT = (bf16_t*)(ws + WS_WIN); bf16_t* WoT = (bf16_t*)(ws + WS_WO); unsigned char* WguT = ws + WS_WGU; unsigned char* WdT = ws + WS_WD;
    bf16_t* XN = (bf16_t*)(ws + WS_XN); bf16_t* Ub = (bf16_t*)(ws + WS_U); bf16_t* Qb = (bf16_t*)(ws + WS_Q); bf16_t* Kb = (bf16_t*)(ws + WS_K); bf16_t* Vb = (bf16_t*)(ws + WS_V);
    bf16_t* OB = (bf16_t*)(ws + WS_OB); float* ML = (float*)(ws + WS_ML); bf16_t* MIX = (bf16_t*)(ws + WS_MIX); float* XMID = (float*)(ws + WS_XMID);
    unsigned char* XS = ws + WS_XS; unsigned char* ACT = ws + WS_ACT; unsigned char* Yb = ws + WS_Y;
    int* TOPI = (int*)(ws + WS_TOPI); float* GATE = (float*)(ws + WS_GATE); int* LRANK = (int*)(ws + WS_LRANK);
    unsigned* CNT = (unsigned*)(ws + WS_CTL) + CW_CNT; int* INV = (int*)(ws + WS_INV);

    for (int u = tid; u < (LDS_BYTES - LDSCTL_OFF) / 4; u += NWAVES * 64) ((LAS unsigned*)(lds + LDSCTL_OFF))[u] = 0u;
    __syncthreads();
    XcdBarrier bar = xcd_barrier_post((unsigned*)(ws + WS_CTL) + CW_BAR, MISC + 8);
    const int gw = vcu * NWAVES + wave, NGW = G * NWAVES;

    {
        LAS unsigned char* scr = lds + wave * 16384;
        constexpr int I_IN = 16 * 32, I_OUT = 8 * 16, NITEMS = I_IN + I_OUT;
        for (int it = gw; it < NITEMS; it += NGW) {
            int r = it;
            if (r < I_IN) { const int kb = r >> 5, nb = r & 31; transpose64(w_in, 2048, WinT, 1024, 64 * kb, 64 * nb, 64 * nb, 64 * kb, scr, lane); continue; } r -= I_IN;
            { const int kb = r >> 4, nb = r & 15; transpose64(w_out + (size_t)512 * 1024, 1024, WoT, 1024, 64 * kb, 64 * nb, 64 * nb, 512 + 64 * kb, scr, lane); }
        }
        for (int q = gw * 64 + lane; q < 4096; q += NGW * 64) { const int e = q & 31, k8 = q >> 5;
            float wv[8], rv[8];
#pragma unroll
            for (int j = 0; j < 8; ++j) wv[j] = w_router[(size_t)(8 * k8 + j) * 32 + e];
            u32x4 H; H.x = pkbf(wv[0], wv[1]); H.y = pkbf(wv[2], wv[3]); H.z = pkbf(wv[4], wv[5]); H.w = pkbf(wv[6], wv[7]);
            rv[0] = wv[0] - bflo(H.x); rv[1] = wv[1] - bfhi(H.x); rv[2] = wv[2] - bflo(H.y); rv[3] = wv[3] - bfhi(H.y); rv[4] = wv[4] - bflo(H.z); rv[5] = wv[5] - bfhi(H.z); rv[6] = wv[6] - bflo(H.w); rv[7] = wv[7] - bfhi(H.w);
            u32x4 L; L.x = pkbf(rv[0], rv[1]); L.y = pkbf(rv[2], rv[3]); L.z = pkbf(rv[4], rv[5]); L.w = pkbf(rv[6], rv[7]);
            *(u32x4*)(ws + WS_TAB + 2048 * e + 16 * (k8 ^ (e & 15))) = H; *(u32x4*)(ws + WS_TAB + 65536 + 2048 * e + 16 * (k8 ^ (e & 15))) = L; }
        for (int it = gw; it < DUPN(10) * 1024; it += NGW) weff_item(w_pool, pool_scale, w_out, WoT, it & 1023, (LAS float*)scr, lane);
        for (int m = gw; m < DUPN(11) * T; m += NGW) rms_row_to_bf16(x + (size_t)(m & (T - 1)) * D, g_mix, XN + (size_t)(m & (T - 1)) * D, lane);
    }
    xcd_barrier(bar);

    {
        pg8::Gemm g{XN, WinT, D}; pg8::StaticOrder S; S.init(T, 2048, D * 2, G, bx);
        pg8::EpiQKV E{Ub, (size_t)T * 512, QSCALE};
        pg8::gemm_phase<pg8::EpiQKV, pg8::StaticOrder, true>(lds, g, S, E);
    }
    xcd_barrier(bar);
#if (PROBE_DUP >> 1) & 1
    {
        pg8::Gemm g{XN, WinT, D}; pg8::StaticOrder S; S.init(T, 2048, D * 2, G, bx);
        pg8::EpiQKV E{Ub, (size_t)T * 512, QSCALE};
        pg8::gemm_phase<pg8::EpiQKV, pg8::StaticOrder, true>(lds, g, S, E);
    }
    xcd_barrier(bar);
#endif

    attn_phase(lds, Qb, Kb, Vb, OB, ML, vcu, G, tid, w_gu, w_down, WguT, WdT);
    xcd_barrier(bar);

    for (int run_ = gw; run_ < DUPN(3) * (T / 8); run_ += NGW) {
        const int run = run_ & (T / 8 - 1);
        const int t0 = run * 8, ts0 = t0 & (SEQ - 1), grp = lane >> 4, w = 2 << grp;
        u32x4 cur[8], old[8];
#pragma unroll
        for (int i = 0; i < 8; ++i) { cur[i] = *(const u32x4*)(Ub + (size_t)(t0 + i) * 512 + 8 * lane);
            const int to = (ts0 + i >= w - 1) ? (t0 + i - w + 1) : (t0 + i);
            old[i] = *(const u32x4*)(Ub + (size_t)to * 512 + 8 * lane); }
        float S[8];
#pragma unroll
        for (int i = 0; i < 8; ++i) S[i] = 0.f;
#pragma unroll
        for (int j = 1; j < 16; ++j) {
            if (j < w && j <= ts0) { const u32x4 v = *(const u32x4*)(Ub + (size_t)(t0 - j) * 512 + 8 * lane);
                S[0] += bflo(v.x); S[1] += bfhi(v.x); S[2] += bflo(v.y); S[3] += bfhi(v.y); S[4] += bflo(v.z); S[5] += bfhi(v.z); S[6] += bflo(v.w); S[7] += bfhi(v.w); }
        }
#pragma unroll
        for (int i = 0; i < 8; ++i) {
            const int t = t0 + i, ts = ts0 + i;
            const float c0 = bflo(cur[i].x), c1 = bfhi(cur[i].x), c2 = bflo(cur[i].y), c3 = bfhi(cur[i].y), c4 = bflo(cur[i].z), c5 = bfhi(cur[i].z), c6 = bflo(cur[i].w), c7 = bfhi(cur[i].w);
            S[0] += c0; S[1] += c1; S[2] += c2; S[3] += c3; S[4] += c4; S[5] += c5; S[6] += c6; S[7] += c7;
            const int cnt = (ts + 1 < w) ? ts + 1 : w; const float ic = 1.0f / (float)cnt;
            u32x4 pw; pw.x = pkbf(S[0] * ic - c0, S[1] * ic - c1); pw.y = pkbf(S[2] * ic - c2, S[3] * ic - c3); pw.z = pkbf(S[4] * ic - c4, S[5] * ic - c5); pw.w = pkbf(S[6] * ic - c6, S[7] * ic - c7);
            *(u32x4*)(MIX + (size_t)t * 1024 + 8 * lane) = pw;
            if (ts >= w - 1) { const u32x4 v = old[i];
                S[0] -= bflo(v.x); S[1] -= bfhi(v.x); S[2] -= bflo(v.y); S[3] -= bfhi(v.y); S[4] -= bflo(v.z); S[5] -= bfhi(v.z); S[6] -= bflo(v.w); S[7] -= bfhi(v.w); }
        }
        const int h = lane >> 3;
#pragma unroll
        for (int bt = 0; bt < 2; ++bt) {
            f32x2 mlv[4][3]; u32x4 ov[4][3];
#pragma unroll
            for (int i = 0; i < 4; ++i)
#pragma unroll
                for (int br = 0; br < 3; ++br) { const int t = t0 + 4 * bt + i;
                    mlv[i][br] = __builtin_nontemporal_load((const f32x2*)(ML + (((size_t)br * T + t) * 8 + h) * 2)); ov[i][br] = __builtin_nontemporal_load((const u32x4*)(OB + ((size_t)br * T + t) * 512 + 8 * lane)); }
#pragma unroll
            for (int i = 0; i < 4; ++i) { const int t = t0 + 4 * bt + i;
                const float mall = fmaxf(mlv[i][0].x, fmaxf(mlv[i][1].x, mlv[i][2].x));
                float w0 = mlv[i][0].y * __builtin_amdgcn_exp2f(mlv[i][0].x - mall), w1 = mlv[i][1].y * __builtin_amdgcn_exp2f(mlv[i][1].x - mall), w2 = mlv[i][2].y * __builtin_amdgcn_exp2f(mlv[i][2].x - mall);
                const float it = 1.0f / (w0 + w1 + w2); w0 *= it; w1 *= it; w2 *= it;
                const u32x4 o0 = ov[i][0], o1 = ov[i][1], o2 = ov[i][2];
                u32x4 aw;
                aw.x = pkbf(w0 * bflo(o0.x) + w1 * bflo(o1.x) + w2 * bflo(o2.x), w0 * bfhi(o0.x) + w1 * bfhi(o1.x) + w2 * bfhi(o2.x));
                aw.y = pkbf(w0 * bflo(o0.y) + w1 * bflo(o1.y) + w2 * bflo(o2.y), w0 * bfhi(o0.y) + w1 * bfhi(o1.y) + w2 * bfhi(o2.y));
                aw.z = pkbf(w0 * bflo(o0.z) + w1 * bflo(o1.z) + w2 * bflo(o2.z), w0 * bfhi(o0.z) + w1 * bfhi(o1.z) + w2 * bfhi(o2.z));
                aw.w = pkbf(w0 * bflo(o0.w) + w1 * bflo(o1.w) + w2 * bflo(o2.w), w0 * bfhi(o0.w) + w1 * bfhi(o1.w) + w2 * bfhi(o2.w));
                *(u32x4*)(MIX + (size_t)t * 1024 + 512 + 8 * lane) = aw; }
        }
    }
    xcd_barrier(bar);

#if (PROBE_DUP >> 14) & 1
    {
        unsigned* CHK = (unsigned*)(ws + WS_CTL) + 2;
        for (int s_ = gw; s_ < 700 * 8; s_ += NGW) {
            const int si = s_ >> 3, h = s_ & 7;
            const int t = (si < 256) ? ((si >> 5) * SEQ + (si & 31) * ((si & 1) ? 1 : 9)) % T : (int)(((long)si * 7919) % T);
            const int ts = t & (SEQ - 1), b = t >> 11;
            float sc[3][3]; float mx = -1e30f;
#pragma unroll
            for (int br = 0; br < 3; ++br) { const int dil = (br == 0) ? 1 : (br == 1 ? 4 : 16);
#pragma unroll
                for (int c = 0; c < 3; ++c) { const int j = lane + 64 * c; float s = -1e30f;
                    if (j <= 128 && j <= ts / dil) { const int tk = b * SEQ + ts - j * dil; float acc = 0.f;
                        for (int d = 0; d < 64; ++d) acc += __uint_as_float((unsigned)Qb[(size_t)t * 512 + h * 64 + d] << 16) * __uint_as_float((unsigned)Kb[(size_t)tk * 512 + h * 64 + d] << 16);
                        s = acc; }
                    sc[br][c] = s; mx = fmaxf(mx, s); } }
#pragma unroll
            for (int o = 1; o < 64; o <<= 1) mx = fmaxf(mx, __shfl_xor(mx, o));
            float lsum = 0.f;
#pragma unroll
            for (int br = 0; br < 3; ++br)
#pragma unroll
                for (int c = 0; c < 3; ++c) { sc[br][c] = __builtin_amdgcn_exp2f(sc[br][c] - mx); lsum += sc[br][c]; }
            lsum = wave_sum(lsum);
            float ov = 0.f;
#pragma unroll
            for (int br = 0; br < 3; ++br) { const int dil = (br == 0) ? 1 : (br == 1 ? 4 : 16);
#pragma unroll
                for (int c = 0; c < 3; ++c)
                    for (int l2 = 0; l2 < 64; ++l2) { const int j = l2 + 64 * c; const float p = __shfl(sc[br][c], l2);
                        if (j <= 128 && j <= ts / dil) { const int tk = b * SEQ + ts - j * dil; ov += p * __uint_as_float((unsigned)Vb[(size_t)tk * 512 + h * 64 + lane] << 16); } } }
            ov /= lsum;
            const float got = __uint_as_float((unsigned)MIX[(size_t)t * 1024 + 512 + h * 64 + lane] << 16);
            bool bad = !(fabsf(got - ov) <= 0.004f + 0.02f * fabsf(ov));
            { const int ch = h * 64 + lane, grp = ch >> 7, w = 2 << grp; const int cnt = (ts + 1 < w) ? ts + 1 : w; float sm = 0.f;
              for (int j = 0; j < cnt; ++j) sm += __uint_as_float((unsigned)Ub[(size_t)(t - j) * 512 + ch] << 16);
              const float pv = sm / (float)cnt - __uint_as_float((unsigned)Ub[(size_t)t * 512 + ch] << 16);
              const float gp = __uint_as_float((unsigned)MIX[(size_t)t * 1024 + ch] << 16);
              bad = bad || !(fabsf(gp - pv) <= 0.004f + 0.02f * fabsf(pv)); }
            if (__any(bad) && lane == 0) atomicAdd(CHK, 1u);
        }
    }
    xcd_barrier(bar);
#endif
    {
        pg8::Gemm g{MIX, WoT, D}; pg8::StaticOrder S; S.init(T, D, D * 2, G, bx);
        pg8::EpiResF32 E{x, XMID};
        pg8::gemm_phase<pg8::EpiResF32, pg8::StaticOrder, true>(lds, g, S, E);
    }
    xcd_barrier(bar);
#if (PROBE_DUP >> 4) & 1
    {
        pg8::Gemm g{MIX, WoT, D}; pg8::StaticOrder S; S.init(T, D, D * 2, G, bx);
        pg8::EpiResF32 E{x, XMID};
        pg8::gemm_phase<pg8::EpiResF32, pg8::StaticOrder, true>(lds, g, S, E);
    }
    xcd_barrier(bar);
#endif

    {
        {
            const u32x4* wri = (const u32x4*)(ws + WS_TAB);
#pragma unroll
            for (int p = 0; p < 16; ++p) *(LAS u32x4*)(lds + (tid + 512 * p) * 16) = wri[tid + 512 * p];
        }
        LAS float* lgf = (LAS float*)(lds + LDS_G_OFF);
        lgf[tid] = g_ffn[tid]; lgf[tid + 512] = g_ffn[tid + 512];
        __syncthreads();
        LAS int* ltopi = (LAS int*)(lds + LDS_TOPI_OFF);
        unsigned char* XG8 = ws + WS_XS; float* RSTD = (float*)(ws + WS_RSTD);
        const int i16 = lane & 15, fq = lane >> 4, ti = i16 & 7;
        if (bx == 0 && wave == 0) *(u32x4*)(XG8 + (size_t)T * 1024 + 16 * lane) = (u32x4){0u, 0u, 0u, 0u};
        float brv[8];
#pragma unroll
        for (int j = 0; j < 8; ++j) brv[j] = b_router[16 * (j >> 2) + 4 * fq + (j & 3)];
        for (int blk_ = vcu; blk_ < (T / 64); blk_ += G) {
            const int blk = blk_ & 255;
            {
                const int tl = 8 * wave + ti, t = 64 * blk + tl;
                const float* xr = XMID + (size_t)t * 1024 + 8 * fq;
                f32x4 acc0 = (f32x4){0.f, 0.f, 0.f, 0.f}, acc1 = (f32x4){0.f, 0.f, 0.f, 0.f}; float ssq = 0.f;
#pragma unroll 8
                for (int ks = 0; ks < 32; ++ks) {
                    const f32x4 xa = __builtin_nontemporal_load((const f32x4*)(xr + 32 * ks)), xb = __builtin_nontemporal_load((const f32x4*)(xr + 32 * ks + 4));
                    const f32x4 ga = *(const LAS f32x4*)(lgf + 32 * ks + 8 * fq), gb = *(const LAS f32x4*)(lgf + 32 * ks + 8 * fq + 4);
                    ssq += (xa.x * xa.x + xa.y * xa.y) + (xa.z * xa.z + xa.w * xa.w) + (xb.x * xb.x + xb.y * xb.y) + (xb.z * xb.z + xb.w * xb.w);
                    const f32x4 ya = xa * ga, yb = xb * gb;
                    u32x4 H; H.x = pkbf(ya.x, ya.y); H.y = pkbf(ya.z, ya.w); H.z = pkbf(yb.x, yb.y); H.w = pkbf(yb.z, yb.w);
                    u32x4 L; L.x = pkbf(ya.x - bflo(H.x), ya.y - bfhi(H.x)); L.y = pkbf(ya.z - bflo(H.y), ya.w - bfhi(H.y)); L.z = pkbf(yb.x - bflo(H.z), yb.y - bfhi(H.z)); L.w = pkbf(yb.z - bflo(H.w), yb.w - bfhi(H.w));
                    u32x2 f8; f8.x = pk4f8(ya.x * XS_SCALE, ya.y * XS_SCALE, ya.z * XS_SCALE, ya.w * XS_SCALE); f8.y = pk4f8(yb.x * XS_SCALE, yb.y * XS_SCALE, yb.z * XS_SCALE, yb.w * XS_SCALE);
                    if (i16 < 8) *(u32x2*)(XG8 + (size_t)t * 1024 + 32 * ks + 8 * fq) = f8;
                    const bf16x8 xh = __builtin_bit_cast(bf16x8, H), xl = __builtin_bit_cast(bf16x8, L);
                    const int ch = 4 * ks + fq;
                    const bf16x8 wh0 = *(const LAS bf16x8*)(lds + 2048 * i16 + 16 * (ch ^ i16)), wl0 = *(const LAS bf16x8*)(lds + 65536 + 2048 * i16 + 16 * (ch ^ i16));
                    const bf16x8 wh1 = *(const LAS bf16x8*)(lds + 2048 * (16 + i16) + 16 * (ch ^ i16)), wl1 = *(const LAS bf16x8*)(lds + 65536 + 2048 * (16 + i16) + 16 * (ch ^ i16));
                    acc0 = __builtin_amdgcn_mfma_f32_16x16x32_bf16(wh0, xh, acc0, 0, 0, 0); acc1 = __builtin_amdgcn_mfma_f32_16x16x32_bf16(wh1, xh, acc1, 0, 0, 0);
                    acc0 = __builtin_amdgcn_mfma_f32_16x16x32_bf16(wl0, xh, acc0, 0, 0, 0); acc1 = __builtin_amdgcn_mfma_f32_16x16x32_bf16(wl1, xh, acc1, 0, 0, 0);
                    acc0 = __builtin_amdgcn_mfma_f32_16x16x32_bf16(wh0, xl, acc0, 0, 0, 0); acc1 = __builtin_amdgcn_mfma_f32_16x16x32_bf16(wh1, xl, acc1, 0, 0, 0);
                }
                ssq += __shfl_xor(ssq, 16); ssq += __shfl_xor(ssq, 32);
                const float rstd = 1.0f / sqrtf(ssq * (1.f / D) + EPS);
                float my[8];
#pragma unroll
                for (int r = 0; r < 4; ++r) { my[r] = acc0[r] * rstd + brv[r]; my[4 + r] = acc1[r] * rstd + brv[4 + r]; }
                float lg[32];
#pragma unroll
                for (int f = 0; f < 4; ++f)
#pragma unroll
                    for (int j = 0; j < 8; ++j) lg[16 * (j >> 2) + 4 * f + (j & 3)] = __shfl(my[j], i16 + 16 * f);
                unsigned taken = 0u; float tv[4]; int tix[4];
#pragma unroll
                for (int r = 0; r < 4; ++r) { float best = -3.0e38f; int bi = 0;
#pragma unroll
                    for (int e = 0; e < 32; ++e) { const bool ok = !((taken >> e) & 1u) && (lg[e] > best); best = ok ? lg[e] : best; bi = ok ? e : bi; }
                    taken |= 1u << bi; tv[r] = best; tix[r] = bi; }
                const float e1 = __expf(tv[1] - tv[0]), e2 = __expf(tv[2] - tv[0]), e3 = __expf(tv[3] - tv[0]); const float is = 1.0f / (1.0f + e1 + e2 + e3);
                if (lane < 8) { *(int4*)(TOPI + (size_t)t * 4) = make_int4(tix[0], tix[1], tix[2], tix[3]); *(f32x4*)(GATE + (size_t)t * 4) = (f32x4){is, e1 * is, e2 * is, e3 * is};
                    RSTD[t] = rstd;
                    ltopi[tl * 4 + 0] = tix[0]; ltopi[tl * 4 + 1] = tix[1]; ltopi[tl * 4 + 2] = tix[2]; ltopi[tl * 4 + 3] = tix[3]; }
            }
            __syncthreads();
            if (wave == 0) {
                const int e0 = ltopi[lane * 4 + 0], e1 = ltopi[lane * 4 + 1], e2 = ltopi[lane * 4 + 2], e3 = ltopi[lane * 4 + 3];
                int r0 = 0, r1 = 0, r2 = 0, r3 = 0, mycnt = 0; const unsigned long long below = (1ull << lane) - 1ull;
                for (int e = 0; e < 32; ++e) { const bool hit = (e0 == e) | (e1 == e) | (e2 == e) | (e3 == e); const unsigned long long mk = __ballot(hit); const int rk = __popcll(mk & below);
                    if (e0 == e) r0 = rk; if (e1 == e) r1 = rk; if (e2 == e) r2 = rk; if (e3 == e) r3 = rk; if (lane == e) mycnt = __popcll(mk); }
                int base = 0; if (lane < 32) base = (int)__hip_atomic_fetch_add(CNT + lane, (unsigned)mycnt, __ATOMIC_RELAXED, __HIP_MEMORY_SCOPE_AGENT);
                r0 += __shfl(base, e0); r1 += __shfl(base, e1); r2 += __shfl(base, e2); r3 += __shfl(base, e3);
                const int tt = 64 * blk + lane;
                *(int4*)(LRANK + (size_t)tt * 4) = make_int4(r0, r1, r2, r3);
                INV[(size_t)e0 * T + r0] = tt; INV[(size_t)e1 * T + r1] = tt; INV[(size_t)e2 * T + r2] = tt; INV[(size_t)e3 * T + r3] = tt;
            }
            __syncthreads();
        }
    }
    xcd_barrier(bar);

    {
        LAS int* ltab = (LAS int*)(lds + LDS_TAB_OFF); LAS int* lnmt = (LAS int*)(lds + LDS_NMT_OFF);
        LAS int* lcnt = (LAS int*)(lds + LDS_P6_OFF), * lO = lcnt + 32;
        LAS int* lrow = (LAS int*)(lds + LDS_ROWT_OFF); LAS float* lrs = (LAS float*)(lds + LDS_RSTB_OFF);
        if (tid < 32) lcnt[tid] = (int)__hip_atomic_load(CNT + tid, __ATOMIC_RELAXED, __HIP_MEMORY_SCOPE_AGENT);
        __syncthreads();
        if (tid == 0) { int off = 0; for (int e = 0; e < 32; ++e) { lO[e] = off; off += ((lcnt[e] + 255) >> 8) << 8; } lO[32] = off; lnmt[0] = off >> 8; }
        __syncthreads();
        const int nmt = rfl(lnmt[0]);
        for (int mt = tid; mt < nmt && mt < 384; mt += NWAVES * 64) { int e = 0; for (int q = 1; q < 32; ++q) e += (lO[q] <= mt * 256) ? 1 : 0; ltab[mt] = e; }
        __syncthreads();
        {
            pg8::GroupedOrder S0; S0.init(nmt, 2048, D, G, bx, ltab, (size_t)2048 * 1024); pg8::Unit u0;
            const float* RSTD = (const float*)(ws + WS_RSTD);
            for (int i = 0; i < MAX_UNITS && S0.next(i, u0); ++i) if (tid < 256) {
                const int e = u0.e, rk = u0.pm * 256 - lO[e] + tid; const bool valid = rk < lcnt[e];
                const int tok = valid ? INV[(size_t)e * T + rk] : T;
                lrow[i * 256 + tid] = tok * 1024; lrs[i * 256 + tid] = valid ? RSTD[tok] : 0.f; }
        }
        __syncthreads();
        {
            pg8::Gemm8 g{XS, WguT, D}; pg8::GroupedOrder S; S.init(nmt, 2048, D, G, bx, ltab, (size_t)2048 * 1024);
            pg8::EpiSwiGLU E{ACT, b_gu, lrs};
            pg8::gemm_phase_f8<pg8::EpiSwiGLU, pg8::GroupedOrder, true, true>(lds, g, S, E, lrow);
        }
        xcd_barrier(bar);
        {
            pg8::Gemm8 g{ACT, WdT, DE}; pg8::GroupedOrder S; S.init(nmt, 1024, DE, G, bx, ltab, (size_t)1024 * 1024);
            pg8::EpiBiasBf16 E{Yb, b_down};
            pg8::gemm_phase_f8<pg8::EpiBiasBf16, pg8::GroupedOrder, true>(lds, g, S, E);
        }
    }
    xcd_barrier(bar);

    {
        unsigned bad = __hip_atomic_load((unsigned*)(ws + WS_CTL) + CW_BAR + XB_TMO, __ATOMIC_RELAXED, __HIP_MEMORY_SCOPE_AGENT);
#if (PROBE_DUP >> 14) & 1
        bad |= __hip_atomic_load((unsigned*)(ws + WS_CTL) + 2, __ATOMIC_RELAXED, __HIP_MEMORY_SCOPE_AGENT);
#endif
        LAS int* lO9 = (LAS int*)(lds + LDS_P6_OFF) + 32;
        __syncthreads();
        if (tid == 0) { int off = 0; for (int e = 0; e < 32; ++e) { lO9[e] = off; off += (((int)__hip_atomic_load(CNT + e, __ATOMIC_RELAXED, __HIP_MEMORY_SCOPE_AGENT) + 255) >> 8) << 8; } }
        __syncthreads();
        for (int t_ = gw; t_ < DUPN(9) * T; t_ += NGW) {
            const int t = t_ & (T - 1);
            const int4 ee = *(const int4*)(TOPI + (size_t)t * 4), rk = *(const int4*)(LRANK + (size_t)t * 4);
            const int4 ps = make_int4(lO9[ee.x] + rk.x, lO9[ee.y] + rk.y, lO9[ee.z] + rk.z, lO9[ee.w] + rk.w); const f32x4 gt = *(const f32x4*)(GATE + (size_t)t * 4);
            const f32x4* xr = (const f32x4*)(XMID + (size_t)t * 1024) + lane; const f32x4* gr = (const f32x4*)g_final + lane;
            const unsigned* y0 = (const unsigned*)(Yb + (size_t)ps.x * 1024) + lane; const unsigned* y1 = (const unsigned*)(Yb + (size_t)ps.y * 1024) + lane;
            const unsigned* y2 = (const unsigned*)(Yb + (size_t)ps.z * 1024) + lane; const unsigned* y3 = (const unsigned*)(Yb + (size_t)ps.w * 1024) + lane;
            const f32x4 gs = gt * (1.0f / Y_SCALE);
            f32x4 v[4]; float s = 0.f;
#pragma unroll
            for (int j = 0; j < 4; ++j) { v[j] = __builtin_nontemporal_load(xr + 64 * j); const int a = (int)__builtin_nontemporal_load(y0 + 64 * j), b = (int)__builtin_nontemporal_load(y1 + 64 * j), c = (int)__builtin_nontemporal_load(y2 + 64 * j), d = (int)__builtin_nontemporal_load(y3 + 64 * j);
                const f32x2 al = __builtin_amdgcn_cvt_pk_f32_fp8(a, false), ah = __builtin_amdgcn_cvt_pk_f32_fp8(a, true), bl = __builtin_amdgcn_cvt_pk_f32_fp8(b, false), bh = __builtin_amdgcn_cvt_pk_f32_fp8(b, true);
                const f32x2 cl = __builtin_amdgcn_cvt_pk_f32_fp8(c, false), chh = __builtin_amdgcn_cvt_pk_f32_fp8(c, true), dl = __builtin_amdgcn_cvt_pk_f32_fp8(d, false), dh = __builtin_amdgcn_cvt_pk_f32_fp8(d, true);
                v[j].x += gs.x * al.x + gs.y * bl.x + gs.z * cl.x + gs.w * dl.x;
                v[j].y += gs.x * al.y + gs.y * bl.y + gs.z * cl.y + gs.w * dl.y;
                v[j].z += gs.x * ah.x + gs.y * bh.x + gs.z * chh.x + gs.w * dh.x;
                v[j].w += gs.x * ah.y + gs.y * bh.y + gs.z * chh.y + gs.w * dh.y;
                s += (v[j].x * v[j].x + v[j].y * v[j].y) + (v[j].z * v[j].z + v[j].w * v[j].w); }
            float rstd = 1.0f / sqrtf(wave_sum(s) * (1.f / D) + EPS);
            if (bad) rstd = __builtin_nanf("");
            f32x4* orow = (f32x4*)(out + (size_t)t * 1024) + lane;
#pragma unroll
            for (int j = 0; j < 4; ++j) { const f32x4 gv = gr[64 * j]; __builtin_nontemporal_store(v[j] * rstd * gv, orow + 64 * j); }
        }
    }
}

extern "C" void kernel_launch(void* const* d_in, const int* in_sizes, int n_in, void* d_out, int out_size, void* d_ws, size_t ws_size, hipStream_t stream) {
    static int grid = 0;
    if (grid == 0) {
        if (n_in != 14 || in_sizes[0] != T * D || out_size != T * D || ws_size < WS_END) { fprintf(stderr, "kernel_launch: unexpected shapes (n_in %d, in0 %d, out %d, ws %zu)\n", n_in, n_in > 0 ? in_sizes[0] : -1, out_size, ws_size); grid = -1; return; }
        int dev = 0, cus = 0, per_cu = 0;
        if (hipGetDevice(&dev) != hipSuccess || hipDeviceGetAttribute(&cus, hipDeviceAttributeMultiprocessorCount, dev) != hipSuccess) { grid = -1; return; }
        if (hipFuncSetAttribute((const void*)mega_fwd, hipFuncAttributeMaxDynamicSharedMemorySize, LDS_BYTES) != hipSuccess) { fprintf(stderr, "kernel_launch: hipFuncSetAttribute failed\n"); grid = -1; return; }
        if (hipOccupancyMaxActiveBlocksPerMultiprocessor(&per_cu, (const void*)mega_fwd, NWAVES * 64, LDS_BYTES) != hipSuccess || per_cu < 1)
            fprintf(stderr, "kernel_launch: note: occupancy query reports %d workgroups per CU\n", per_cu);
        (void)hipGetLastError();
        grid = cus;
    }
    if (grid < 0) return;
    if (hipMemsetAsync((char*)d_ws + WS_CTL, 0, CTL_ZERO_BYTES, stream) != hipSuccess) return;
    Args a{};
    for (int i = 0; i < 14; ++i) a.in[i] = (const float*)d_in[i];
    a.out = (float*)d_out; a.ws = (unsigned char*)d_ws;
    hipLaunchKernelGGL(mega_fwd, dim3(grid), dim3(NWAVES * 64), LDS_BYTES, stream, a);
}
```

```cpp
#include <hip/hip_runtime.h>
#include <cstdio>
#include <cstdint>
#ifndef PROBE_DUP
#define PROBE_DUP 0
#endif
#define DUPN(k) (((PROBE_DUP >> (k)) & 1) ? 2 : 1)

#define GAS __attribute__((address_space(1)))
#define LAS __attribute__((address_space(3)))
typedef unsigned short bf16_t;
typedef short bf16x8 __attribute__((ext_vector_type(8)));
typedef float f32x4 __attribute__((ext_vector_type(4)));
typedef float f32x2 __attribute__((ext_vector_type(2)));
typedef unsigned u32x4 __attribute__((ext_vector_type(4)));
typedef unsigned u32x2 __attribute__((ext_vector_type(2)));
typedef __bf16 bf16x2_t __attribute__((ext_vector_type(2)));
typedef short v4i16_t __attribute__((ext_vector_type(4)));

__device__ __forceinline__ unsigned pkbf(float lo, float hi) { f32x2 v = {lo, hi}; bf16x2_t b = __builtin_convertvector(v, bf16x2_t); return __builtin_bit_cast(unsigned, b); }
__device__ __forceinline__ float bflo(unsigned w) { return __uint_as_float(w << 16); }
__device__ __forceinline__ float bfhi(unsigned w) { return __uint_as_float(w & 0xffff0000u); }
__device__ __forceinline__ int rfl(int v) { return __builtin_amdgcn_readfirstlane(v); }

constexpr int T = 16384, D = 1024, SEQ = 2048, NH = 8, HD = 64, DP = 512, DA = 512, NE = 32, TOPK = 4, DE = 1024;
constexpr float EPS = 1e-5f;
constexpr int MAXROWS = 73728;
constexpr float QSCALE = 0.125f * 1.4426950408889634f;

constexpr float W_SCALE = 64.0f, XS_SCALE = 16.0f, ACT_SCALE = 4.0f, Y_SCALE = 16.0f;
__device__ __forceinline__ float clamp448(float v) { return fminf(fmaxf(v, -448.0f), 448.0f); }
__device__ __forceinline__ unsigned pk4f8(float a, float b, float c, float d) {
    int w = __builtin_amdgcn_cvt_pk_fp8_f32(clamp448(a), clamp448(b), 0, false);
    w = __builtin_amdgcn_cvt_pk_fp8_f32(clamp448(c), clamp448(d), w, true);
    return (unsigned)w;
}
typedef int v8i32 __attribute__((ext_vector_type(8)));
namespace pg8 {
constexpr int BM = 256, BK = 64, HALF = 128, HTB = HALF * BK * 2, STAGE_BYTES = 8 * HTB, NXCD = 8, WGM = 8;
__host__ __device__ __forceinline__ int lds_byte(int r, int c) { const int st = (r >> 4) * 2 + (c >> 5), rr = r & 15, cc = c & 31, ob = rr * 64 + cc * 2; return st * 1024 + (ob ^ (((ob >> 9) & 1) << 5)); }
__host__ __device__ __forceinline__ void stage_rc(int b, int& R, int& C) { const int st = b / 1024, sb = b % 1024, swz = sb ^ (((sb >> 9) & 1) << 5); R = (st >> 1) * 16 + swz / 64; C = (st & 1) * 32 + (swz % 64) / 2; }
__host__ __device__ __forceinline__ int perm32(int rho) { const int n = rho >> 4, i = rho & 15; return 8 * (i >> 2) + 4 * n + (i & 3); }

struct Unit { int pm, pn, e, ui; };
struct Gemm { const bf16_t* A; const bf16_t* Bt; int K; };

struct StaticOrder {
    int nM, nN, nwg, G, c, rb;
    __device__ void init(int M, int N, int rb_, int G_, int c_) { nM = M / BM; nN = N / BM; nwg = nM * nN; G = G_; c = c_; rb = rb_; }
    __device__ __forceinline__ bool next(int i, Unit& u) const {
        const long L = (long)i * G + c; if (L >= nwg) return false;
        int wgid = (int)L; { const int q = nwg / NXCD, r = nwg % NXCD, xcd = wgid % NXCD, off = wgid / NXCD; wgid = (xcd < r ? xcd * (q + 1) : r * (q + 1) + (xcd - r) * q) + off; }
        const int nig = WGM * nN, gid = wgid / nig, fm = gid * WGM, gsz = (nM - fm) < WGM ? (nM - fm) : WGM;
        u.pm = fm + ((wgid % nig) % gsz); u.pn = (wgid % nig) / gsz; u.e = 0; u.ui = i; return true;
    }
    __device__ __forceinline__ size_t a_off(const Unit& u) const { return (size_t)u.pm * BM * rb; }
    __device__ __forceinline__ size_t b_off(const Unit& u) const { return (size_t)u.pn * BM * rb; }
};
struct GroupedOrder {
    int nM, nN, nwg, G, c, rb; const LAS int* tab; size_t bexp;
    __device__ void init(int nM_, int N, int rb_, int G_, int c_, const LAS int* tab_, size_t bexp_) { nM = nM_; nN = N / BM; nwg = nM * nN; G = G_; c = c_; rb = rb_; tab = tab_; bexp = bexp_; }
    __device__ __forceinline__ bool next(int i, Unit& u) const {
        const long L = (long)i * G + c; if (L >= nwg) return false;
        int wgid = (int)L; { const int q = nwg / NXCD, r = nwg % NXCD, xcd = wgid % NXCD, off = wgid / NXCD; wgid = (xcd < r ? xcd * (q + 1) : r * (q + 1) + (xcd - r) * q) + off; }
        const int nig = WGM * nN, gid = wgid / nig, fm = gid * WGM, gsz = (nM - fm) < WGM ? (nM - fm) : WGM;
        u.pm = fm + ((wgid % nig) % gsz); u.pn = (wgid % nig) / gsz; u.e = __builtin_amdgcn_readfirstlane(tab[u.pm]); u.ui = i; return true;
    }
    __device__ __forceinline__ size_t a_off(const Unit& u) const { return (size_t)u.pm * BM * rb; }
    __device__ __forceinline__ size_t b_off(const Unit& u) const { return (size_t)u.e * bexp + (size_t)u.pn * BM * rb; }
};

struct EpiQKV {
    static constexpr bool PERM = true;
    bf16_t* O; size_t stride; float qscale;
    __device__ __forceinline__ void operator()(const f32x4 (&acc)[2][2][4][2], const Unit& u, int wr, int wc, int fr, int fq) const {
        const int t = u.pn >> 1; bf16_t* base = O + (size_t)t * stride; const float sc = (t == 1) ? qscale : 1.f;
        const int row0 = u.pm * BM + wr * 64 + fr, col0 = (u.pn & 1) * BM + wc * 32 + 8 * fq;
#pragma unroll
        for (int ai = 0; ai < 2; ++ai)
#pragma unroll
            for (int m = 0; m < 4; ++m) { bf16_t* rowp = base + (size_t)(row0 + ai * HALF + m * 16) * 512 + col0;
#pragma unroll
                for (int bj = 0; bj < 2; ++bj) { const f32x4 v0 = acc[ai][bj][m][0] * sc, v1 = acc[ai][bj][m][1] * sc;
                    u32x4 w; w.x = pkbf(v0[0], v0[1]); w.y = pkbf(v0[2], v0[3]); w.z = pkbf(v1[0], v1[1]); w.w = pkbf(v1[2], v1[3]);
                    *(u32x4*)(rowp + bj * HALF) = w; } }
    }
};
struct EpiResF32 {
    static constexpr bool PERM = false;
    const float* base; float* out;
    __device__ __forceinline__ void operator()(const f32x4 (&acc)[2][2][4][2], const Unit& u, int wr, int wc, int fr, int fq) const {
        const int col0 = u.pn * BM + wc * 32 + 4 * fq;
#pragma unroll
        for (int ai = 0; ai < 2; ++ai)
#pragma unroll
            for (int m = 0; m < 4; ++m) { const size_t off = (size_t)(u.pm * BM + ai * HALF + wr * 64 + m * 16 + fr) * 1024 + col0;
#pragma unroll
                for (int bj = 0; bj < 2; ++bj)
#pragma unroll
                    for (int n = 0; n < 2; ++n) { const f32x4 bs = __builtin_nontemporal_load((const f32x4*)(base + off + bj * HALF + n * 16)); *(f32x4*)(out + off + bj * HALF + n * 16) = bs + acc[ai][bj][m][n]; } }
    }
};
struct EpiSwiGLU {
    static constexpr bool PERM = true;
    unsigned char* O; const float* bgu; const LAS float* rs;
    __device__ __forceinline__ void operator()(const f32x4 (&acc)[2][2][4][2], const Unit& u, int wr, int wc, int fr, int fq) const {
        const int row0 = u.pm * BM + wr * 64 + fr, jc0 = wc * 32 + 8 * fq;
        const float* bg = bgu + (size_t)u.e * 2048 + u.pn * 128 + jc0; const float* bl = bg + 1024;
        f32x4 bgv[2], blv[2];
#pragma unroll
        for (int n = 0; n < 2; ++n) { bgv[n] = *(const f32x4*)(bg + 4 * n); blv[n] = *(const f32x4*)(bl + 4 * n); }
        const int odd = fq & 1;
        unsigned char* cbase = O + (size_t)(row0 + odd * 16) * 1024 + u.pn * 128 + wc * 32 + 8 * (fq - odd);
#pragma unroll
        for (int ai = 0; ai < 2; ++ai)
#pragma unroll
            for (int mp = 0; mp < 2; ++mp) {
                u32x2 w2[2];
#pragma unroll
                for (int mm = 0; mm < 2; ++mm) { const int m = 2 * mp + mm;
                    const float rsc = rs[u.ui * 256 + wr * 64 + fr + ai * HALF + m * 16] * (1.0f / (W_SCALE * XS_SCALE));
                    float a[8];
#pragma unroll
                    for (int n = 0; n < 2; ++n) { const f32x4 g4 = acc[ai][0][m][n] * rsc + bgv[n], l4 = acc[ai][1][m][n] * rsc + blv[n];
#pragma unroll
                        for (int j = 0; j < 4; ++j) { const float gate = fminf(g4[j], 7.0f); const float lin = fminf(fmaxf(l4[j], -7.0f), 7.0f);
                            const float sg = __builtin_amdgcn_rcpf(1.0f + __builtin_amdgcn_exp2f(gate * (-1.702f * 1.4426950408889634f)));
                            a[4 * n + j] = gate * sg * (lin + 1.0f) * ACT_SCALE; } }
                    w2[mm].x = pk4f8(a[0], a[1], a[2], a[3]); w2[mm].y = pk4f8(a[4], a[5], a[6], a[7]); }
                const auto sx = __builtin_amdgcn_permlane16_swap(w2[0].x, w2[1].x, false, false), sy = __builtin_amdgcn_permlane16_swap(w2[0].y, w2[1].y, false, false);
                u32x4 o; o.x = sx[0]; o.y = sy[0]; o.z = sx[1]; o.w = sy[1];
                *(u32x4*)(cbase + (size_t)(ai * HALF + mp * 32) * 1024) = o; }
    }
};
struct EpiBiasBf16 {
    static constexpr bool PERM = true;
    unsigned char* O; const float* bias;
    __device__ __forceinline__ void operator()(const f32x4 (&acc)[2][2][4][2], const Unit& u, int wr, int wc, int fr, int fq) const {
        const int row0 = u.pm * BM + wr * 64 + fr, col0 = u.pn * BM + wc * 32 + 8 * fq;
        const float* bp = bias + (size_t)u.e * 1024 + col0;
        f32x4 bv[2][2];
#pragma unroll
        for (int bj = 0; bj < 2; ++bj)
#pragma unroll
            for (int n = 0; n < 2; ++n) bv[bj][n] = *(const f32x4*)(bp + bj * HALF + 4 * n);
        const int odd = fq & 1;
        unsigned char* cbase = O + (size_t)(row0 + odd * 16) * 1024 + u.pn * BM + wc * 32 + 8 * (fq - odd);
#pragma unroll
        for (int ai = 0; ai < 2; ++ai)
#pragma unroll
            for (int mp = 0; mp < 2; ++mp)
#pragma unroll
                for (int bj = 0; bj < 2; ++bj) {
                    u32x2 w2[2];
#pragma unroll
                    for (int mm = 0; mm < 2; ++mm) { const int m = 2 * mp + mm;
                        const f32x4 v0 = (acc[ai][bj][m][0] * (1.0f / (W_SCALE * ACT_SCALE)) + bv[bj][0]) * Y_SCALE, v1 = (acc[ai][bj][m][1] * (1.0f / (W_SCALE * ACT_SCALE)) + bv[bj][1]) * Y_SCALE;
                        w2[mm].x = pk4f8(v0[0], v0[1], v0[2], v0[3]); w2[mm].y = pk4f8(v1[0], v1[1], v1[2], v1[3]); }
                    const auto sx = __builtin_amdgcn_permlane16_swap(w2[0].x, w2[1].x, false, false), sy = __builtin_amdgcn_permlane16_swap(w2[0].y, w2[1].y, false, false);
                    u32x4 o; o.x = sx[0]; o.y = sy[0]; o.z = sx[1]; o.w = sy[1];
                    *(u32x4*)(cbase + (size_t)(ai * HALF + mp * 32) * 1024 + bj * HALF) = o; }
    }
};

template <class Epi, class Sched, bool ALIGN_EPI>
__device__ __forceinline__ void gemm_phase(LAS unsigned char* lds, const Gemm g, const Sched& S, const Epi& E) {
    const int tid = threadIdx.x, wid = __builtin_amdgcn_readfirstlane(tid >> 6), lane = tid & 63, wr = wid >> 2, wc = wid & 3, fr = lane & 15, fq = lane >> 4;
    const int K = g.K, nt = K / BK;
    unsigned voffA, voffB;
    { int R, C; stage_rc(tid * 16, R, C); const int Rb = Epi::PERM ? ((R & ~31) + perm32(R & 31)) : R;
        voffA = (unsigned)(R * K + C) * 2u; voffB = (unsigned)(Rb * K + C) * 2u; }
    const size_t pstep = (size_t)64 * K * 2;
    const size_t kstep = (size_t)(BK * 2);
    const size_t hstep = (size_t)HALF * K * 2;
    const unsigned ldsw = (unsigned)wid * 1024u;
    const int aoff = lds_byte(wr * 64 + fr, fq * 8), boff = lds_byte(wc * 32 + fr, fq * 8);
#define PG8_SA(b, h) (((b) * 2 + (h)) * HTB)
#define PG8_SB(b, h) ((4 + (b) * 2 + (h)) * HTB)
#define PG8_STAGE(bufoff, gbase, voff) do { _Pragma("unroll") for (int _i = 0; _i < 2; ++_i) \
        __builtin_amdgcn_global_load_lds((const unsigned*)((const char*)(gbase) + _i * pstep + (voff)), (LAS unsigned*)(lds + (bufoff) + ldsw + _i * 8192), 16, 0, 0); } while (0)
#define PG8_LDA(dst, b, h) do { _Pragma("unroll") for (int m = 0; m < 4; ++m) _Pragma("unroll") for (int k = 0; k < 2; ++k) dst[m][k] = *(const LAS bf16x8*)(lds + PG8_SA(b, h) + aoff + m * 2048 + k * 1024); } while (0)
#define PG8_LDB(dst, b, h) do { _Pragma("unroll") for (int n = 0; n < 2; ++n) _Pragma("unroll") for (int k = 0; k < 2; ++k) dst[n][k] = *(const LAS bf16x8*)(lds + PG8_SB(b, h) + boff + n * 2048 + k * 1024); } while (0)
#define PG8_MMA(ai, bj, At, Bt) do { __builtin_amdgcn_s_setprio(1); _Pragma("unroll") for (int m = 0; m < 4; ++m) _Pragma("unroll") for (int n = 0; n < 2; ++n) _Pragma("unroll") for (int k = 0; k < 2; ++k) \
        acc[ai][bj][m][n] = __builtin_amdgcn_mfma_f32_16x16x32_bf16(Bt[n][k], At[m][k], acc[ai][bj][m][n], 0, 0, 0); __builtin_amdgcn_s_setprio(0); } while (0)
#define PG8_WAIT_V(n) asm volatile("s_waitcnt vmcnt(" #n ")" ::: "memory")
#define PG8_WAIT_L(n) asm volatile("s_waitcnt lgkmcnt(" #n ")" ::: "memory")
#define PG8_BAR __builtin_amdgcn_s_barrier()
#define PG8_SCHED __builtin_amdgcn_sched_barrier(0)
    Unit cur, nxt; int ui = 0;
    if (!S.next(0, cur)) return;
    f32x4 acc[2][2][4][2];
#pragma unroll
    for (int a = 0; a < 2; ++a)
#pragma unroll
        for (int b = 0; b < 2; ++b)
#pragma unroll
            for (int m = 0; m < 4; ++m)
#pragma unroll
                for (int n = 0; n < 2; ++n) acc[a][b][m][n] = (f32x4){0.f, 0.f, 0.f, 0.f};
    bf16x8 At[4][2], B0[2][2], B1[2][2];
    const char* cA = (const char*)g.A + S.a_off(cur); const char* cB = (const char*)g.Bt + S.b_off(cur);
    PG8_STAGE(PG8_SB(0, 0), cB, voffB); PG8_STAGE(PG8_SB(0, 1), cB + hstep, voffB); PG8_STAGE(PG8_SA(0, 0), cA, voffA); PG8_STAGE(PG8_SA(0, 1), cA + hstep, voffA);
    if (wr == 1) PG8_BAR;
    PG8_WAIT_V(2); PG8_BAR;
    PG8_STAGE(PG8_SB(1, 0), cB + kstep, voffB); PG8_STAGE(PG8_SA(1, 0), cA + kstep, voffA); PG8_STAGE(PG8_SB(1, 1), cB + hstep + kstep, voffB);
    PG8_WAIT_V(6); PG8_BAR;
    for (;;) {
        const bool has_next = S.next(ui + 1, nxt);
        const char* nA = has_next ? (const char*)g.A + S.a_off(nxt) : cA; const char* nB = has_next ? (const char*)g.Bt + S.b_off(nxt) : cB;
#pragma nounroll
        for (int t = 0; t < nt; t += 2) {
            const bool last = (t == nt - 2);
            const char* a1 = cA + (size_t)(t + 1) * kstep;
            const char* a2 = last ? nA : cA + (size_t)(t + 2) * kstep; const char* b2 = last ? nB : cB + (size_t)(t + 2) * kstep;
            const char* a3 = a2 + kstep; const char* b3 = b2 + kstep;
            PG8_LDB(B0, 0, 0); PG8_LDB(B1, 0, 1); PG8_SCHED; PG8_LDA(At, 0, 0); PG8_STAGE(PG8_SA(1, 1), a1 + hstep, voffA);
            PG8_WAIT_V(8); PG8_WAIT_L(0); PG8_BAR; PG8_MMA(0, 0, At, B0); PG8_MMA(0, 1, At, B1); PG8_BAR; PG8_SCHED;
            PG8_LDA(At, 0, 1); PG8_STAGE(PG8_SB(0, 0), b2, voffB); PG8_STAGE(PG8_SB(0, 1), b2 + hstep, voffB); PG8_STAGE(PG8_SA(0, 0), a2, voffA);
            PG8_WAIT_V(8); PG8_WAIT_L(0); PG8_BAR; PG8_MMA(1, 0, At, B0); PG8_MMA(1, 1, At, B1); PG8_BAR; PG8_SCHED;
            PG8_LDB(B0, 1, 0); PG8_LDB(B1, 1, 1); PG8_SCHED; PG8_LDA(At, 1, 0); PG8_STAGE(PG8_SA(0, 1), a2 + hstep, voffA);
            PG8_WAIT_V(8); PG8_WAIT_L(0); PG8_BAR; PG8_MMA(0, 0, At, B0); PG8_MMA(0, 1, At, B1); PG8_BAR; PG8_SCHED;
            PG8_LDA(At, 1, 1); PG8_STAGE(PG8_SB(1, 0), b3, voffB); PG8_STAGE(PG8_SB(1, 1), b3 + hstep, voffB); PG8_STAGE(PG8_SA(1, 0), a3, voffA);
            PG8_WAIT_V(8); PG8_WAIT_L(0); PG8_BAR; PG8_MMA(1, 0, At, B0); PG8_MMA(1, 1, At, B1); PG8_BAR; PG8_SCHED;
        }
        if constexpr (ALIGN_EPI) { if (wr == 0) PG8_BAR; }
        E(acc, cur, wr, wc, fr, fq);
        if (!has_next) break;
#pragma unroll
        for (int a = 0; a < 2; ++a)
#pragma unroll
            for (int b = 0; b < 2; ++b)
#pragma unroll
                for (int m = 0; m < 4; ++m)
#pragma unroll
                    for (int n = 0; n < 2; ++n) acc[a][b][m][n] = (f32x4){0.f, 0.f, 0.f, 0.f};
        cur = nxt; cA = nA; cB = nB; ++ui;
        if constexpr (ALIGN_EPI) { if (wr == 1) PG8_BAR; }
    }
    PG8_WAIT_V(0);
    if constexpr (!ALIGN_EPI) { if (wr == 0) PG8_BAR; }
    PG8_BAR;
#undef PG8_SA
#undef PG8_SB
#undef PG8_STAGE
#undef PG8_LDA
#undef PG8_LDB
#undef PG8_MMA
#undef PG8_WAIT_V
#undef PG8_WAIT_L
#undef PG8_BAR
#undef PG8_SCHED
}
__host__ __device__ __forceinline__ int f8swz(int r) { return ((r >> 2) & 1) | (((r >> 1) & 1) << 2); }
struct Gemm8 { const unsigned char* A; const unsigned char* Bt; int Kb; };
template <class Epi, class Sched, bool ALIGN_EPI, bool GATHER = false>
__device__ __forceinline__ void gemm_phase_f8(LAS unsigned char* lds, const Gemm8 g, const Sched& S, const Epi& E, const LAS int* rowtab = nullptr) {
    const int tid = threadIdx.x, wid = __builtin_amdgcn_readfirstlane(tid >> 6), lane = tid & 63, wr = wid >> 2, wc = wid & 3, fr = lane & 15, fq = lane >> 4;
    const int Kb = g.Kb, nt = Kb / 128;
    unsigned voffA, voffB;
    { const int b = tid * 16, R = b >> 7, c = ((b >> 4) & 7) ^ f8swz(R & 15); const int Rb = Epi::PERM ? ((R & ~31) + perm32(R & 31)) : R;
        voffA = (unsigned)(R * Kb + 16 * c); voffB = (unsigned)(Rb * Kb + 16 * c); }
    const size_t pstep = (size_t)64 * Kb;
    const size_t kstep = 128;
    const int gc16 = 16 * ((tid & 7) ^ f8swz((tid >> 3) & 15));
    unsigned offC[2][2], offN[2][2];
#define PG8_ROWOFF(dst, uidx) do { _Pragma("unroll") for (int _h = 0; _h < 2; ++_h) _Pragma("unroll") for (int _i = 0; _i < 2; ++_i) dst[_h][_i] = (unsigned)(rowtab[(uidx) * 256 + _h * 128 + _i * 64 + (tid >> 3)] + gc16); } while (0)
#define PG8_STAGE_G(bufoff, kbyte, offs, h) do { _Pragma("unroll") for (int _i = 0; _i < 2; ++_i) \
        __builtin_amdgcn_global_load_lds((const unsigned*)((const char*)g.A + (kbyte) + (offs)[h][_i]), (LAS unsigned*)(lds + (bufoff) + ldsw + _i * 8192), 16, 0, 0); } while (0)
#define PG8_STAGE_A(b, h, ptr, kbyte, offs) do { if constexpr (GATHER) PG8_STAGE_G(PG8_SA(b, h), kbyte, offs, h); else PG8_STAGE(PG8_SA(b, h), (ptr) + (h) * hstep, voffA); } while (0)
    const size_t hstep = (size_t)HALF * Kb;
    const unsigned ldsw = (unsigned)wid * 1024u;
    LAS unsigned char* ab0 = lds + 128 * (wr * 64 + fr) + 16 * ((2 * fq) ^ f8swz(fr)); LAS unsigned char* ab1 = lds + 128 * (wr * 64 + fr) + 16 * ((2 * fq + 1) ^ f8swz(fr));
    LAS unsigned char* bb0 = lds + 65536 + 128 * (wc * 32 + fr) + 16 * ((2 * fq) ^ f8swz(fr)); LAS unsigned char* bb1 = lds + 65536 + 128 * (wc * 32 + fr) + 16 * ((2 * fq + 1) ^ f8swz(fr));
    asm volatile("" : "+v"(ab0), "+v"(ab1), "+v"(bb0), "+v"(bb1));
#define PG8_SA(b, h) (((b) * 2 + (h)) * HTB)
#define PG8_SB(b, h) ((4 + (b) * 2 + (h)) * HTB)
#define PG8_STAGE(bufoff, gbase, voff) do { _Pragma("unroll") for (int _i = 0; _i < 2; ++_i) \
        __builtin_amdgcn_global_load_lds((const unsigned*)((const char*)(gbase) + _i * pstep + (voff)), (LAS unsigned*)(lds + (bufoff) + ldsw + _i * 8192), 16, 0, 0); } while (0)
#define PG8_LDA(dst, b, h) do { _Pragma("unroll") for (int m = 0; m < 4; ++m) { dst[m][0] = *(const LAS u32x4*)(ab0 + PG8_SA(b, h) + m * 2048); dst[m][1] = *(const LAS u32x4*)(ab1 + PG8_SA(b, h) + m * 2048); } } while (0)
#define PG8_LDB(dst, b, h) do { _Pragma("unroll") for (int n = 0; n < 2; ++n) { dst[n][0] = *(const LAS u32x4*)(bb0 + PG8_SA(b, h) + n * 2048); dst[n][1] = *(const LAS u32x4*)(bb1 + PG8_SA(b, h) + n * 2048); } } while (0)
#define PG8_CAT(x) __builtin_bit_cast(v8i32, __builtin_shufflevector((x)[0], (x)[1], 0, 1, 2, 3, 4, 5, 6, 7))
#define PG8_MMA(ai, bj, At, Bt) do { __builtin_amdgcn_s_setprio(1); _Pragma("unroll") for (int m = 0; m < 4; ++m) _Pragma("unroll") for (int n = 0; n < 2; ++n) \
        asm volatile("v_mfma_f32_16x16x128_f8f6f4 %0, %1, %2, %0" : "+v"(acc[ai][bj][m][n]) : "v"(PG8_CAT(Bt[n])), "v"(PG8_CAT(At[m]))); __builtin_amdgcn_s_setprio(0); } while (0)
#define PG8_WAIT_V(n) asm volatile("s_waitcnt vmcnt(" #n ")" ::: "memory")
#define PG8_WAIT_L(n) asm volatile("s_waitcnt lgkmcnt(" #n ")" ::: "memory")
#define PG8_BAR __builtin_amdgcn_s_barrier()
#define PG8_SCHED __builtin_amdgcn_sched_barrier(0)
    Unit cur, nxt; int ui = 0;
    if (!S.next(0, cur)) return;
    f32x4 acc[2][2][4][2];
#pragma unroll
    for (int a = 0; a < 2; ++a)
#pragma unroll
        for (int b = 0; b < 2; ++b)
#pragma unroll
            for (int m = 0; m < 4; ++m)
#pragma unroll
                for (int n = 0; n < 2; ++n) acc[a][b][m][n] = (f32x4){0.f, 0.f, 0.f, 0.f};
    u32x4 At[4][2], B0[2][2], B1[2][2];
    const char* cA = (const char*)g.A + (GATHER ? 0 : S.a_off(cur)); const char* cB = (const char*)g.Bt + S.b_off(cur);
    if constexpr (GATHER) { PG8_ROWOFF(offC, 0); }
    PG8_STAGE(PG8_SB(0, 0), cB, voffB); PG8_STAGE(PG8_SB(0, 1), cB + hstep, voffB); PG8_STAGE_A(0, 0, cA, 0, offC); PG8_STAGE_A(0, 1, cA, 0, offC);
    if (wr == 1) PG8_BAR;
    PG8_WAIT_V(2); PG8_BAR;
    PG8_STAGE(PG8_SB(1, 0), cB + kstep, voffB); PG8_STAGE_A(1, 0, cA + kstep, 128, offC); PG8_STAGE(PG8_SB(1, 1), cB + hstep + kstep, voffB);
    PG8_WAIT_V(6); PG8_BAR;
    for (;;) {
        const bool has_next = S.next(ui + 1, nxt);
        const char* nA = (has_next && !GATHER) ? (const char*)g.A + S.a_off(nxt) : cA; const char* nB = has_next ? (const char*)g.Bt + S.b_off(nxt) : cB;
        if constexpr (GATHER) { if (has_next) { PG8_ROWOFF(offN, ui + 1); } else {
#pragma unroll
            for (int _h = 0; _h < 2; ++_h)
#pragma unroll
                for (int _i = 0; _i < 2; ++_i) offN[_h][_i] = offC[_h][_i]; } }
#pragma nounroll
        for (int t = 0; t < nt; t += 2) {
            const bool last = (t == nt - 2);
            const char* a1 = cA + (size_t)(t + 1) * kstep;
            const char* a2 = last ? nA : cA + (size_t)(t + 2) * kstep; const char* b2 = last ? nB : cB + (size_t)(t + 2) * kstep;
            const char* a3 = a2 + kstep; const char* b3 = b2 + kstep;
            const int kb1 = (t + 1) * 128, kb2 = last ? 0 : (t + 2) * 128, kb3 = kb2 + 128;
            unsigned off2[2][2];
            if constexpr (GATHER) {
#pragma unroll
                for (int _h = 0; _h < 2; ++_h)
#pragma unroll
                    for (int _i = 0; _i < 2; ++_i) off2[_h][_i] = last ? offN[_h][_i] : offC[_h][_i]; }
            PG8_LDB(B0, 0, 0); PG8_LDB(B1, 0, 1); PG8_SCHED; PG8_LDA(At, 0, 0); PG8_STAGE_A(1, 1, a1, kb1, offC);
            PG8_WAIT_V(8); PG8_WAIT_L(0); PG8_BAR; PG8_MMA(0, 0, At, B0); PG8_MMA(0, 1, At, B1); PG8_BAR; PG8_SCHED;
            PG8_LDA(At, 0, 1); PG8_STAGE(PG8_SB(0, 0), b2, voffB); PG8_STAGE(PG8_SB(0, 1), b2 + hstep, voffB); PG8_STAGE_A(0, 0, a2, kb2, off2);
            PG8_WAIT_V(8); PG8_WAIT_L(0); PG8_BAR; PG8_MMA(1, 0, At, B0); PG8_MMA(1, 1, At, B1); PG8_BAR; PG8_SCHED;
            PG8_LDB(B0, 1, 0); PG8_LDB(B1, 1, 1); PG8_SCHED; PG8_LDA(At, 1, 0); PG8_STAGE_A(0, 1, a2, kb2, off2);
            PG8_WAIT_V(8); PG8_WAIT_L(0); PG8_BAR; PG8_MMA(0, 0, At, B0); PG8_MMA(0, 1, At, B1); PG8_BAR; PG8_SCHED;
            PG8_LDA(At, 1, 1); PG8_STAGE(PG8_SB(1, 0), b3, voffB); PG8_STAGE(PG8_SB(1, 1), b3 + hstep, voffB); PG8_STAGE_A(1, 0, a3, kb3, off2);
            PG8_WAIT_V(8); PG8_WAIT_L(0); PG8_BAR; PG8_MMA(1, 0, At, B0); PG8_MMA(1, 1, At, B1); PG8_BAR; PG8_SCHED;
        }
        if constexpr (ALIGN_EPI) { if (wr == 0) PG8_BAR; }
        asm volatile("s_nop 15\n\ts_nop 7" ::: "memory");
        E(acc, cur, wr, wc, fr, fq);
        if (!has_next) break;
#pragma unroll
        for (int a = 0; a < 2; ++a)
#pragma unroll
            for (int b = 0; b < 2; ++b)
#pragma unroll
                for (int m = 0; m < 4; ++m)
#pragma unroll
                    for (int n = 0; n < 2; ++n) acc[a][b][m][n] = (f32x4){0.f, 0.f, 0.f, 0.f};
        cur = nxt; cA = nA; cB = nB; ++ui;
        if constexpr (GATHER) {
#pragma unroll
            for (int _h = 0; _h < 2; ++_h)
#pragma unroll
                for (int _i = 0; _i < 2; ++_i) offC[_h][_i] = offN[_h][_i]; }
        if constexpr (ALIGN_EPI) { if (wr == 1) PG8_BAR; }
    }
    PG8_WAIT_V(0);
    if constexpr (!ALIGN_EPI) { if (wr == 0) PG8_BAR; }
    PG8_BAR;
#undef PG8_ROWOFF
#undef PG8_STAGE_G
#undef PG8_STAGE_A
#undef PG8_SA
#undef PG8_SB
#undef PG8_STAGE
#undef PG8_LDA
#undef PG8_LDB
#undef PG8_CAT
#undef PG8_MMA
#undef PG8_WAIT_V
#undef PG8_WAIT_L
#undef PG8_BAR
#undef PG8_SCHED
}
}

constexpr size_t MiB = 1u << 20;
constexpr size_t WS_CTL = 0, CTL_ZERO_BYTES = 32768;
constexpr size_t WS_WIN = 1 * MiB, WS_WO = 5 * MiB;
constexpr size_t WS_TAB = 7 * MiB;
constexpr size_t WS_TOPI = 8 * MiB, WS_GATE = WS_TOPI + 256 * 1024, WS_LRANK = WS_GATE + 256 * 1024, WS_POS = WS_LRANK + 256 * 1024;
constexpr size_t WS_RSTD = 12 * MiB, WS_INV = 13 * MiB;
constexpr int CW_CNT = 256;
constexpr size_t WS_ML = 9 * MiB;
constexpr size_t WS_WGU = 16 * MiB, WS_WD = 144 * MiB, WS_XN = 208 * MiB;
constexpr size_t WS_U = 240 * MiB, WS_Q = 256 * MiB, WS_K = 272 * MiB, WS_V = 288 * MiB;
constexpr size_t WS_OB = 304 * MiB, WS_MIX = 352 * MiB, WS_XMID = 384 * MiB, WS_XS = 448 * MiB, WS_ACT = 592 * MiB, WS_Y = 736 * MiB, WS_END = 880 * MiB;
constexpr int CW_BAR = 4096;

constexpr int RING_BYTES = 131072, LDSCTL_OFF = RING_BYTES, MISC_OFF = LDSCTL_OFF + 320;
constexpr int LDS_NMT_OFF = LDSCTL_OFF + 512, LDS_TAB_OFF = LDSCTL_OFF + 1024, LDS_TOPI_OFF = LDSCTL_OFF + 4096, LDS_P6_OFF = LDSCTL_OFF + 8192, LDS_G_OFF = LDSCTL_OFF + 8192, LDS_ROWT_OFF = LDSCTL_OFF + 12288;
constexpr int MAX_UNITS = 10;
constexpr int LDS_RSTB_OFF = LDS_ROWT_OFF + MAX_UNITS * 1024;
constexpr int LDS_BYTES = 163840;

#define XB_TMO      128
#define XB_XCNT(j)  (256  + 64 * (j))
#define XB_XSUB(j)  (1280 + 64 * (j))
#define XB_XGEN(j)  (2304 + 64 * (j))
#define XB_TOP      3328
#define XB_TOPGEN   3392
#define XCD_BAR_WORDS 3456
#define XB_SPIN_CAP (1u << 18)
__device__ __forceinline__ unsigned xb_ld(unsigned* p)              { return __hip_atomic_load(p, __ATOMIC_RELAXED, __HIP_MEMORY_SCOPE_AGENT); }
__device__ __forceinline__ unsigned xb_add(unsigned* p, unsigned v) { return __hip_atomic_fetch_add(p, v, __ATOMIC_RELAXED, __HIP_MEMORY_SCOPE_AGENT); }
__device__ __forceinline__ unsigned xb_xcc_id() { return (unsigned)__builtin_amdgcn_s_getreg((3 << 11) | 20) & 0xFu; }
#define XB_SPIN(cond, bar) do { unsigned _sp = 0; while (cond) { __builtin_amdgcn_s_sleep(1); \
    if ((++_sp & 255u) == 0u) { if (xb_ld(&(bar)[XB_TMO])) break; if (_sp > XB_SPIN_CAP) { atomicAdd(&(bar)[XB_TMO], 1u); break; } } } } while (0)
struct XcdBarrier { unsigned* bar; unsigned x; volatile LAS unsigned* st; };
__device__ __forceinline__ XcdBarrier xcd_barrier_post(unsigned* bar, volatile LAS unsigned* st) {
    XcdBarrier b; b.bar = bar; b.x = xb_xcc_id(); b.st = st;
    if (threadIdx.x == 0) (void)xb_add(&bar[XB_XCNT(b.x)], 1u);
    return b;
}
__device__ __forceinline__ void xcd_barrier_complete(unsigned* bar, unsigned x, unsigned& nloc, unsigned& nx) {
    const unsigned G = gridDim.x * gridDim.y * gridDim.z;
    unsigned sum, cnt, mine, sp = 0u;
    for (;;) {
        sum = 0u; cnt = 0u; mine = 0u;
#pragma unroll
        for (unsigned j = 0; j < 16; ++j) { const unsigned c = xb_ld(&bar[XB_XCNT(j)]); sum += c; cnt += (c > 0u) ? 1u : 0u; mine = (j == x) ? c : mine; }
        if (sum == G) break;
        __builtin_amdgcn_s_sleep(1);
        if ((++sp & 255u) == 0u) { if (xb_ld(&bar[XB_TMO])) break; if (sp > XB_SPIN_CAP) { atomicAdd(&bar[XB_TMO], 1u); break; } }
    }
    nloc = mine > 0u ? mine : 1u; nx = cnt > 0u ? cnt : 1u;
}
__device__ __forceinline__ void xcd_barrier(const XcdBarrier& b) {
    asm volatile("s_waitcnt vmcnt(0)" ::: "memory");
    __syncthreads();
    if (threadIdx.x == 0) {
        unsigned* bar = b.bar;
        __builtin_amdgcn_s_waitcnt(0);
        unsigned nloc = b.st[0], nx = b.st[1];
        if (nloc == 0u) { xcd_barrier_complete(bar, b.x, nloc, nx); b.st[0] = nloc; b.st[1] = nx; }
        const unsigned old = xb_add(&bar[XB_XSUB(b.x)], 1u);
        const unsigned gen = old / nloc;
        if (old + 1u == (gen + 1u) * nloc) {
            __builtin_amdgcn_fence(__ATOMIC_RELEASE, "agent");
            asm volatile("s_waitcnt vmcnt(0)" ::: "memory");
            const unsigned og = xb_add(&bar[XB_TOP], 1u);
            const unsigned tg = og / nx;
            if (og + 1u == (tg + 1u) * nx) xb_add(&bar[XB_TOPGEN], 1u);
            else XB_SPIN(xb_ld(&bar[XB_TOPGEN]) == tg, bar);
            __builtin_amdgcn_fence(__ATOMIC_ACQUIRE, "agent");
            xb_add(&bar[XB_XGEN(b.x)], 1u);
            asm volatile("s_waitcnt vmcnt(0)" ::: "memory");
        } else {
            XB_SPIN(xb_ld(&bar[XB_XGEN(b.x)]) == gen, bar);
            __builtin_amdgcn_fence(__ATOMIC_ACQUIRE, "agent");
            asm volatile("s_waitcnt vmcnt(0)" ::: "memory");
        }
    }
    __syncthreads();
}

__device__ __forceinline__ float wave_sum(float v) {
#pragma unroll
    for (int o = 1; o < 64; o <<= 1) v += __shfl_xor(v, o);
    return v;
}
__device__ __forceinline__ void rms_row_to_bf16(const float* xrow, const float* g, bf16_t* orow, int lane) {
    const f32x4* xr = (const f32x4*)xrow + lane; const f32x4* gr = (const f32x4*)g + lane;
    f32x4 v[4]; float s = 0.f;
#pragma unroll
    for (int j = 0; j < 4; ++j) { v[j] = __builtin_nontemporal_load(xr + 64 * j); s += (v[j].x * v[j].x + v[j].y * v[j].y) + (v[j].z * v[j].z + v[j].w * v[j].w); }
    const float rstd = 1.0f / sqrtf(wave_sum(s) * (1.f / D) + EPS);
    u32x2* o8 = (u32x2*)orow + lane;
#pragma unroll
    for (int j = 0; j < 4; ++j) { const f32x4 gv = gr[64 * j]; u32x2 w; w.x = pkbf(v[j].x * rstd * gv.x, v[j].y * rstd * gv.y); w.y = pkbf(v[j].z * rstd * gv.z, v[j].w * rstd * gv.w); o8[64 * j] = w; }
}
__device__ __forceinline__ void transpose64(const float* W, int ldn, bf16_t* WT, int ldk, int k0, int n0, int drow0, int dcol0, LAS unsigned char* scr, int lane) {
    const int nc = lane & 15, kq = lane >> 4;
    const float* src = W + (size_t)(k0 + 16 * kq) * ldn + n0 + 4 * nc;
    f32x4 v[16];
#pragma unroll
    for (int it = 0; it < 16; ++it) v[it] = *(const f32x4*)(src + (size_t)it * ldn);
    const int x = nc & 7;
#pragma unroll
    for (int c = 0; c < 4; ++c) { const int n = 4 * nc + c;
        u32x4 lo, hi;
        lo.x = pkbf(v[0][c], v[1][c]); lo.y = pkbf(v[2][c], v[3][c]); lo.z = pkbf(v[4][c], v[5][c]); lo.w = pkbf(v[6][c], v[7][c]);
        hi.x = pkbf(v[8][c], v[9][c]); hi.y = pkbf(v[10][c], v[11][c]); hi.z = pkbf(v[12][c], v[13][c]); hi.w = pkbf(v[14][c], v[15][c]);
        *(LAS u32x4*)(scr + 128 * n + 16 * ((2 * kq) ^ x)) = lo;
        *(LAS u32x4*)(scr + 128 * n + 16 * ((2 * kq + 1) ^ x)) = hi; }
#pragma unroll
    for (int j = 0; j < 8; ++j) { const int n = (lane >> 3) + 8 * j, c = lane & 7, xx = (n >> 2) & 7;
        const u32x4 o = *(const LAS u32x4*)(scr + 128 * n + 16 * (c ^ xx));
        *(u32x4*)(WT + (size_t)(drow0 + n) * ldk + dcol0 + 8 * c) = o; }
}
__device__ __forceinline__ void weff_item(const float* w_pool, const float* pool_scale, const float* w_out, bf16_t* WoT, int item, LAS float* scr, int lane) {
    const int nb = item & 15, cb = (item >> 4) & 15, g = item >> 8;
#pragma unroll
    for (int q = 0; q < 16; ++q) { const int idx = lane + 64 * q, i = idx >> 7, dp = idx & 127; scr[idx] = w_pool[(size_t)(g * 128 + 8 * cb + i) * 128 + dp] * pool_scale[g * 128 + dp]; }
    float acc[8];
#pragma unroll
    for (int i = 0; i < 8; ++i) acc[i] = 0.f;
    const float* wo = w_out + (size_t)(g * 128) * 1024 + nb * 64 + lane;
    for (int dp = 0; dp < 128; dp += 4) {
        const float w0 = wo[(size_t)(dp + 0) * 1024], w1 = wo[(size_t)(dp + 1) * 1024], w2 = wo[(size_t)(dp + 2) * 1024], w3 = wo[(size_t)(dp + 3) * 1024];
#pragma unroll
        for (int i = 0; i < 8; ++i) { const f32x4 s = *(const LAS f32x4*)(scr + i * 128 + dp); acc[i] += (s.x * w0 + s.y * w1) + (s.z * w2 + s.w * w3); }
    }
    u32x4 o; o.x = pkbf(acc[0], acc[1]); o.y = pkbf(acc[2], acc[3]); o.z = pkbf(acc[4], acc[5]); o.w = pkbf(acc[6], acc[7]);
    *(u32x4*)(WoT + (size_t)(nb * 64 + lane) * 1024 + g * 128 + 8 * cb) = o;
}

constexpr int I_GU = 32 * 8 * 32, I_DN = 32 * 8 * 16, N_WITEMS = I_GU + I_DN;
struct WItem { const float* src; unsigned char* dst; int ldn; };
__device__ __forceinline__ WItem witem_decode(int r, const float* w_gu, const float* w_down, unsigned char* WguT, unsigned char* WdT) {
    WItem w;
    if (r < I_GU) { const int e = r >> 8, kb = (r >> 5) & 7, nb = r & 31, n0 = 64 * nb;
        const int drow = (n0 < 1024) ? ((n0 >> 7) * 256 + (n0 & 127)) : (((n0 - 1024) >> 7) * 256 + 128 + ((n0 - 1024) & 127));
        w.src = w_gu + (size_t)e * 1024 * 2048 + (size_t)(128 * kb) * 2048 + n0; w.dst = WguT + (size_t)e * 2048 * 1024 + (size_t)drow * 1024 + 128 * kb; w.ldn = 2048; }
    else { r -= I_GU; const int e = r >> 7, kb = (r >> 4) & 7, nb = r & 15;
        w.src = w_down + (size_t)e * 1024 * 1024 + (size_t)(128 * kb) * 1024 + 64 * nb; w.dst = WdT + (size_t)e * 1024 * 1024 + (size_t)(64 * nb) * 1024 + 128 * kb; w.ldn = 1024; }
    return w;
}
__device__ __forceinline__ void witem_issue(const WItem& w, int half, f32x4 (&v)[16], int lane) {
    const int nc = lane & 15, kq = lane >> 4;
    const float* src = w.src + (size_t)(32 * kq + 16 * half) * w.ldn + 4 * nc;
#pragma unroll
    for (int it = 0; it < 16; ++it) v[it] = __builtin_nontemporal_load((const f32x4*)(src + (size_t)it * w.ldn));
}
__device__ __forceinline__ void witem_finish(const WItem& w, int half, const f32x4 (&v)[16], LAS unsigned char* scr, int lane) {
    const int nc = lane & 15, kq = lane >> 4, x = nc & 7;
#pragma unroll
    for (int c = 0; c < 4; ++c) { const int n = 4 * nc + c;
        u32x4 q; q.x = pk4f8(v[0][c] * W_SCALE, v[1][c] * W_SCALE, v[2][c] * W_SCALE, v[3][c] * W_SCALE); q.y = pk4f8(v[4][c] * W_SCALE, v[5][c] * W_SCALE, v[6][c] * W_SCALE, v[7][c] * W_SCALE);
        q.z = pk4f8(v[8][c] * W_SCALE, v[9][c] * W_SCALE, v[10][c] * W_SCALE, v[11][c] * W_SCALE); q.w = pk4f8(v[12][c] * W_SCALE, v[13][c] * W_SCALE, v[14][c] * W_SCALE, v[15][c] * W_SCALE);
        *(LAS u32x4*)(scr + 128 * n + 16 * ((2 * kq + half) ^ x)) = q; }
    if (half == 1) {
#pragma unroll
        for (int j = 0; j < 8; ++j) { const int n = (lane >> 3) + 8 * j, c = lane & 7, xx = (n >> 2) & 7;
            const u32x4 o = *(const LAS u32x4*)(scr + 128 * n + 16 * (c ^ xx));
            __builtin_nontemporal_store(o, (u32x4*)(w.dst + (size_t)n * 1024 + 16 * c)); }
    }
}

struct AttU { int b, h, br, dil, r, n; };
__device__ __forceinline__ AttU att_decode(int u) {
    u = u % 3072; AttU a; const int bh = u / 48, sub = u % 48; a.b = bh >> 3; a.h = bh & 7; a.br = sub >> 4; const int j = sub & 15;
    if (a.br == 0) { a.dil = 1; a.r = 0; a.n = j; } else if (a.br == 1) { a.dil = 4; a.r = j >> 2; a.n = j & 3; } else { a.dil = 16; a.r = j; a.n = 0; }
    return a;
}
__device__ __forceinline__ void attn_phase(LAS unsigned char* lds, const bf16_t* Qb, const bf16_t* Kb, const bf16_t* Vb, bf16_t* OB, float* ML, int vcu, int G, int tid,
                                           const float* w_gu, const float* w_down, unsigned char* WguT, unsigned char* WdT) {
    constexpr int NU = 64 * 48 * DUPN(2);
    const int lane = tid & 63, wid = rfl(tid >> 6), i16 = lane & 15, fq = lane >> 4;
    const int gwv = vcu * 8 + wid, NGWv = G * 8;
    LAS unsigned char* wscr = lds + 65536 + wid * 8192;
    f32x4 wv[16]; WItem wi; wi.src = nullptr; wi.dst = nullptr; wi.ldn = 0;
    int step = 0;
    u32x4 kreg[4], vreg[4], qreg[2];
    int u = vcu;
    if (u < NU) { const AttU a = att_decode(u);
#pragma unroll
        for (int p = 0; p < 4; ++p) { const int q = tid + 512 * p, row = q >> 3, c = q & 7; int cp = (a.n - 1) * 128 + row; cp = cp < 0 ? 0 : cp;
            const size_t off = (size_t)(a.b * SEQ + cp * a.dil + a.r) * 512 + a.h * 64 + c * 8; kreg[p] = *(const u32x4*)(Kb + off); vreg[p] = *(const u32x4*)(Vb + off); }
        const bf16_t* qp = Qb + (size_t)(a.b * SEQ + (a.n * 128 + 16 * wid + i16) * a.dil + a.r) * 512 + a.h * 64 + 8 * fq;
        qreg[0] = *(const u32x4*)(qp); qreg[1] = *(const u32x4*)(qp + 32); }
    bool wact = (u < NU) && (gwv < N_WITEMS);
    if (wact) { wi = witem_decode(gwv, w_gu, w_down, WguT, WdT); witem_issue(wi, 0, wv, lane); }
    for (; u < NU; u += G, ++step) {
        const AttU a = att_decode(u);
#pragma unroll
        for (int p = 0; p < 4; ++p) { const int q = tid + 512 * p, row = q >> 3, c = q & 7;
            *(LAS u32x4*)(lds + 128 * row + 16 * (c ^ ((row >> 1) & 7))) = kreg[p];
            *(LAS u32x4*)(lds + 32768 + 128 * row + 32 * ((c >> 1) ^ ((row >> 1) & 3)) + 16 * (c & 1)) = vreg[p]; }
        const bf16x8 qf0 = __builtin_bit_cast(bf16x8, qreg[0]), qf1 = __builtin_bit_cast(bf16x8, qreg[1]);
        __syncthreads();
        const int un = u + G;
        if (un < NU) { const AttU a2 = att_decode(un);
#pragma unroll
            for (int p = 0; p < 4; ++p) { const int q = tid + 512 * p, row = q >> 3, c = q & 7; int cp = (a2.n - 1) * 128 + row; cp = cp < 0 ? 0 : cp;
                const size_t off = (size_t)(a2.b * SEQ + cp * a2.dil + a2.r) * 512 + a2.h * 64 + c * 8; kreg[p] = *(const u32x4*)(Kb + off); vreg[p] = *(const u32x4*)(Vb + off); }
            const bf16_t* qp = Qb + (size_t)(a2.b * SEQ + (a2.n * 128 + 16 * wid + i16) * a2.dil + a2.r) * 512 + a2.h * 64 + 8 * fq;
            qreg[0] = *(const u32x4*)(qp); qreg[1] = *(const u32x4*)(qp + 32); }
        asm volatile("" ::: "memory");
        const int qi = 16 * wid + i16;
        const size_t tokq = (size_t)(a.b * SEQ + (a.n * 128 + qi) * a.dil + a.r);
        f32x4 sc[9];
#pragma unroll
        for (int kt = 0; kt < 9; ++kt) { const int row = 16 * (wid + kt) + i16, xr = (row >> 1) & 7;
            const bf16x8 a0 = *(const LAS bf16x8*)(lds + 128 * row + 16 * (fq ^ xr)), a1 = *(const LAS bf16x8*)(lds + 128 * row + 16 * ((4 + fq) ^ xr));
            f32x4 z = (f32x4){0.f, 0.f, 0.f, 0.f};
            z = __builtin_amdgcn_mfma_f32_16x16x32_bf16(a0, qf0, z, 0, 0, 0);
            sc[kt] = __builtin_amdgcn_mfma_f32_16x16x32_bf16(a1, qf1, z, 0, 0, 0); }
        float mx = -1e30f;
#pragma unroll
        for (int kt = 0; kt < 9; ++kt)
#pragma unroll
            for (int j = 0; j < 4; ++j) { bool valid = true; if (kt == 0) valid = (i16 <= 4 * fq + j); if (kt == 8) valid = (4 * fq + j <= i16);
                if (a.n == 0 && wid + kt < 8) valid = false;
                const float s = valid ? sc[kt][j] : -1e30f; sc[kt][j] = s; mx = fmaxf(mx, s); }
        mx = fmaxf(mx, __shfl_xor(mx, 16)); mx = fmaxf(mx, __shfl_xor(mx, 32));
        float l = 0.f;
#pragma unroll
        for (int kt = 0; kt < 9; ++kt)
#pragma unroll
            for (int j = 0; j < 4; ++j) { const float p = __builtin_amdgcn_exp2f(sc[kt][j] - mx); sc[kt][j] = p; l += p; }
        l += __shfl_xor(l, 16); l += __shfl_xor(l, 32);
        f32x4 o[4];
#pragma unroll
        for (int dt = 0; dt < 4; ++dt) o[dt] = (f32x4){0.f, 0.f, 0.f, 0.f};
        const int qq = i16 >> 2, pp = i16 & 3;
#pragma unroll
        for (int sl = 0; sl < 5; ++sl) {
            const int row0 = 16 * (wid + 2 * sl) + 4 * fq + qq, row1 = (sl == 4) ? row0 : row0 + 16;
            u32x4 pw; pw.x = pkbf(sc[2 * sl][0], sc[2 * sl][1]); pw.y = pkbf(sc[2 * sl][2], sc[2 * sl][3]);
            if (sl < 4) { pw.z = pkbf(sc[(2 * sl + 1) % 9][0], sc[(2 * sl + 1) % 9][1]); pw.w = pkbf(sc[(2 * sl + 1) % 9][2], sc[(2 * sl + 1) % 9][3]); } else { pw.z = 0u; pw.w = 0u; }
            const bf16x8 pf = __builtin_bit_cast(bf16x8, pw);
#pragma unroll
            for (int dt = 0; dt < 4; ++dt) {
                const v4i16_t t0 = __builtin_amdgcn_ds_read_tr16_b64_v4i16((LAS v4i16_t*)(lds + 32768 + 128 * row0 + 32 * (dt ^ ((row0 >> 1) & 3)) + 8 * pp));
                const v4i16_t t1 = __builtin_amdgcn_ds_read_tr16_b64_v4i16((LAS v4i16_t*)(lds + 32768 + 128 * row1 + 32 * (dt ^ ((row1 >> 1) & 3)) + 8 * pp));
                const bf16x8 af = (bf16x8){t0[0], t0[1], t0[2], t0[3], t1[0], t1[1], t1[2], t1[3]};
                o[dt] = __builtin_amdgcn_mfma_f32_16x16x32_bf16(af, pf, o[dt], 0, 0, 0);
            }
        }
        const float inv = 1.0f / l;
        bf16_t* op = OB + ((size_t)a.br * T + tokq) * 512 + a.h * 64 + 4 * fq;
#pragma unroll
        for (int dt = 0; dt < 4; ++dt) { u32x2 w; w.x = pkbf(o[dt][0] * inv, o[dt][1] * inv); w.y = pkbf(o[dt][2] * inv, o[dt][3] * inv); *(u32x2*)(op + 16 * dt) = w; }
        if (fq == 0) { f32x2 ml; ml.x = mx; ml.y = l; *(f32x2*)(ML + (((size_t)a.br * T + tokq) * 8 + a.h) * 2) = ml; }
        if (wact) witem_finish(wi, step & 1, wv, wscr, lane);
        {
            const int ns = step + 1, nitem = gwv + (ns >> 1) * NGWv; const bool nact = (u + G < NU) && (nitem < N_WITEMS);
            if (nact) { if ((ns & 1) == 0) wi = witem_decode(nitem, w_gu, w_down, WguT, WdT); witem_issue(wi, ns & 1, wv, lane); }
            wact = nact;
        }
        __syncthreads();
    }
    if (step & 1) { const int witem = gwv + (step >> 1) * NGWv; if (witem < N_WITEMS) { witem_issue(wi, 1, wv, lane); witem_finish(wi, 1, wv, wscr, lane); } ++step; }
    for (int witem = gwv + (step >> 1) * NGWv; witem < N_WITEMS; witem += NGWv) { wi = witem_decode(witem, w_gu, w_down, WguT, WdT);
        witem_issue(wi, 0, wv, lane); witem_finish(wi, 0, wv, wscr, lane); witem_issue(wi, 1, wv, lane); witem_finish(wi, 1, wv, wscr, lane); }
}

struct Args { const float* in[14]; float* out; unsigned char* ws; };
constexpr int NWAVES = 8;

__global__ void __launch_bounds__(NWAVES * 64, 2) mega_fwd(Args args) {
    extern __shared__ __attribute__((aligned(16))) unsigned char lds_raw[];
    LAS unsigned char* lds = (LAS unsigned char*)lds_raw;
    volatile LAS unsigned* MISC = (volatile LAS unsigned*)(lds + MISC_OFF);
    const int tid = threadIdx.x, lane = tid & 63, wave = rfl(tid >> 6);
    const int G = gridDim.x; const int bx = blockIdx.x; const int vcu = (G % 8 == 0) ? (bx % 8) * (G / 8) + bx / 8 : bx;
    unsigned char* ws = args.ws;
    const float* x = args.in[0]; const float* g_mix = args.in[1]; const float* w_in = args.in[2]; const float* w_pool = args.in[3]; const float* pool_scale = args.in[4];
    const float* w_out = args.in[5]; const float* g_ffn = args.in[6]; const float* w_router = args.in[7]; const float* b_router = args.in[8];
    const float* w_gu = args.in[9]; const float* b_gu = args.in[10]; const float* w_down = args.in[11]; const float* b_down = args.in[12]; const float* g_final = args.in[13];
    float* out = args.out;
    bf16_t* WinT = (bf16_t*)(ws + WS_WIN); bf16_t* WoT = (bf16_t*)(ws + WS_WO); unsigned char* WguT = ws + WS_WGU; unsigned char* WdT = ws + WS_WD;
    bf16_t* XN = (bf16_t*)(ws + WS_XN); bf16_t* Ub = (bf16_t*)(ws + WS_U); bf16_t* Qb = (bf16_t*)(ws + WS_Q); bf16_t* Kb = (bf16_t*)(ws + WS_K); bf16_t* Vb = (bf16_t*)(ws + WS_V);
    bf16_t* OB = (bf16_t*)(ws + WS_OB); float* ML = (float*)(ws + WS_ML); bf16_t* MIX = (bf16_t*)(ws + WS_MIX); float* XMID = (float*)(ws + WS_XMID);
    unsigned char* XS = ws + WS_XS; unsigned char* ACT = ws + WS_ACT; unsigned char* Yb = ws + WS_Y;
    int* TOPI = (int*)(ws + WS_TOPI); float* GATE = (float*)(ws + WS_GATE); int* LRANK = (int*)(ws + WS_LRANK);
    unsigned* CNT = (unsigned*)(ws + WS_CTL) + CW_CNT; int* INV = (int*)(ws + WS_INV);

    for (int u = tid; u < (LDS_BYTES - LDSCTL_OFF) / 4; u += NWAVES * 64) ((LAS unsigned*)(lds + LDSCTL_OFF))[u] = 0u;
    __syncthreads();
    XcdBarrier bar = xcd_barrier_post((unsigned*)(ws + WS_CTL) + CW_BAR, MISC + 8);
    const int gw = vcu * NWAVES + wave, NGW = G * NWAVES;

    {
        LAS unsigned char* scr = lds + wave * 16384;
        constexpr int I_IN = 16 * 32, I_OUT = 8 * 16, NITEMS = I_IN + I_OUT;
        for (int it = gw; it < NITEMS; it += NGW) {
            int r = it;
            if (r < I_IN) { const int kb = r >> 5, nb = r & 31; transpose64(w_in, 2048, WinT, 1024, 64 * kb, 64 * nb, 64 * nb, 64 * kb, scr, lane); continue; } r -= I_IN;
            { const int kb = r >> 4, nb = r & 15; transpose64(w_out + (size_t)512 * 1024, 1024, WoT, 1024, 64 * kb, 64 * nb, 64 * nb, 512 + 64 * kb, scr, lane); }
        }
        for (int q = gw * 64 + lane; q < 4096; q += NGW * 64) { const int e = q & 31, k8 = q >> 5;
            float wv[8], rv[8];
#pragma unroll
            for (int j = 0; j < 8; ++j) wv[j] = w_router[(size_t)(8 * k8 + j) * 32 + e];
            u32x4 H; H.x = pkbf(wv[0], wv[1]); H.y = pkbf(wv[2], wv[3]); H.z = pkbf(wv[4], wv[5]); H.w = pkbf(wv[6], wv[7]);
            rv[0] = wv[0] - bflo(H.x); rv[1] = wv[1] - bfhi(H.x); rv[2] = wv[2] - bflo(H.y); rv[3] = wv[3] - bfhi(H.y); rv[4] = wv[4] - bflo(H.z); rv[5] = wv[5] - bfhi(H.z); rv[6] = wv[6] - bflo(H.w); rv[7] = wv[7] - bfhi(H.w);
            u32x4 L; L.x = pkbf(rv[0], rv[1]); L.y = pkbf(rv[2], rv[3]); L.z = pkbf(rv[4], rv[5]); L.w = pkbf(rv[6], rv[7]);
            *(u32x4*)(ws + WS_TAB + 2048 * e + 16 * (k8 ^ (e & 15))) = H; *(u32x4*)(ws + WS_TAB + 65536 + 2048 * e + 16 * (k8 ^ (e & 15))) = L; }
        for (int it = gw; it < DUPN(10) * 1024; it += NGW) weff_item(w_pool, pool_scale, w_out, WoT, it & 1023, (LAS float*)scr, lane);
        for (int m = gw; m < DUPN(11) * T; m += NGW) rms_row_to_bf16(x + (size_t)(m & (T - 1)) * D, g_mix, XN + (size_t)(m & (T - 1)) * D, lane);
    }
    xcd_barrier(bar);

    {
        pg8::Gemm g{XN, WinT, D}; pg8::StaticOrder S; S.init(T, 2048, D * 2, G, bx);
        pg8::EpiQKV E{Ub, (size_t)T * 512, QSCALE};
        pg8::gemm_phase<pg8::EpiQKV, pg8::StaticOrder, true>(lds, g, S, E);
    }
    xcd_barrier(bar);
#if (PROBE_DUP >> 1) & 1
    {
        pg8::Gemm g{XN, WinT, D}; pg8::StaticOrder S; S.init(T, 2048, D * 2, G, bx);
        pg8::EpiQKV E{Ub, (size_t)T * 512, QSCALE};
        pg8::gemm_phase<pg8::EpiQKV, pg8::StaticOrder, true>(lds, g, S, E);
    }
    xcd_barrier(bar);
#endif

    attn_phase(lds, Qb, Kb, Vb, OB, ML, vcu, G, tid, w_gu, w_down, WguT, WdT);
    xcd_barrier(bar);

    for (int run_ = gw; run_ < DUPN(3) * (T / 8); run_ += NGW) {
        const int run = run_ & (T / 8 - 1);
        const int t0 = run * 8, ts0 = t0 & (SEQ - 1), grp = lane >> 4, w = 2 << grp;
        u32x4 cur[8], old[8];
#pragma unroll
        for (int i = 0; i < 8; ++i) { cur[i] = *(const u32x4*)(Ub + (size_t)(t0 + i) * 512 + 8 * lane);
            const int to = (ts0 + i >= w - 1) ? (t0 + i - w + 1) : (t0 + i);
            old[i] = *(const u32x4*)(Ub + (size_t)to * 512 + 8 * lane); }
        float S[8];
#pragma unroll
        for (int i = 0; i < 8; ++i) S[i] = 0.f;
#pragma unroll
        for (int j = 1; j < 16; ++j) {
            if (j < w && j <= ts0) { const u32x4 v = *(const u32x4*)(Ub + (size_t)(t0 - j) * 512 + 8 * lane);
                S[0] += bflo(v.x); S[1] += bfhi(v.x); S[2] += bflo(v.y); S[3] += bfhi(v.y); S[4] += bflo(v.z); S[5] += bfhi(v.z); S[6] += bflo(v.w); S[7] += bfhi(v.w); }
        }
#pragma unroll
        for (int i = 0; i < 8; ++i) {
            const int t = t0 + i, ts = ts0 + i;
            const float c0 = bflo(cur[i].x), c1 = bfhi(cur[i].x), c2 = bflo(cur[i].y), c3 = bfhi(cur[i].y), c4 = bflo(cur[i].z), c5 = bfhi(cur[i].z), c6 = bflo(cur[i].w), c7 = bfhi(cur[i].w);
            S[0] += c0; S[1] += c1; S[2] += c2; S[3] += c3; S[4] += c4; S[5] += c5; S[6] += c6; S[7] += c7;
            const int cnt = (ts + 1 < w) ? ts + 1 : w; const float ic = 1.0f / (float)cnt;
            u32x4 pw; pw.x = pkbf(S[0] * ic - c0, S[1] * ic - c1); pw.y = pkbf(S[2] * ic - c2, S[3] * ic - c3); pw.z = pkbf(S[4] * ic - c4, S[5] * ic - c5); pw.w = pkbf(S[6] * ic - c6, S[7] * ic - c7);
            *(u32x4*)(MIX + (size_t)t * 1024 + 8 * lane) = pw;
            if (ts >= w - 1) { const u32x4 v = old[i];
                S[0] -= bflo(v.x); S[1] -= bfhi(v.x); S[2] -= bflo(v.y); S[3] -= bfhi(v.y); S[4] -= bflo(v.z); S[5] -= bfhi(v.z); S[6] -= bflo(v.w); S[7] -= bfhi(v.w); }
        }
        const int h = lane >> 3;
#pragma unroll
        for (int bt = 0; bt < 2; ++bt) {
            f32x2 mlv[4][3]; u32x4 ov[4][3];
#pragma unroll
            for (int i = 0; i < 4; ++i)
#pragma unroll
                for (int br = 0; br < 3; ++br) { const int t = t0 + 4 * bt + i;
                    mlv[i][br] = __builtin_nontemporal_load((const f32x2*)(ML + (((size_t)br * T + t) * 8 + h) * 2)); ov[i][br] = __builtin_nontemporal_load((const u32x4*)(OB + ((size_t)br * T + t) * 512 + 8 * lane)); }
#pragma unroll
            for (int i = 0; i < 4; ++i) { const int t = t0 + 4 * bt + i;
                const float mall = fmaxf(mlv[i][0].x, fmaxf(mlv[i][1].x, mlv[i][2].x));
                float w0 = mlv[i][0].y * __builtin_amdgcn_exp2f(mlv[i][0].x - mall), w1 = mlv[i][1].y * __builtin_amdgcn_exp2f(mlv[i][1].x - mall), w2 = mlv[i][2].y * __builtin_amdgcn_exp2f(mlv[i][2].x - mall);
                const float it = 1.0f / (w0 + w1 + w2); w0 *= it; w1 *= it; w2 *= it;
                const u32x4 o0 = ov[i][0], o1 = ov[i][1], o2 = ov[i][2];
                u32x4 aw;
                aw.x = pkbf(w0 * bflo(o0.x) + w1 * bflo(o1.x) + w2 * bflo(o2.x), w0 * bfhi(o0.x) + w1 * bfhi(o1.x) + w2 * bfhi(o2.x));
                aw.y = pkbf(w0 * bflo(o0.y) + w1 * bflo(o1.y) + w2 * bflo(o2.y), w0 * bfhi(o0.y) + w1 * bfhi(o1.y) + w2 * bfhi(o2.y));
                aw.z = pkbf(w0 * bflo(o0.z) + w1 * bflo(o1.z) + w2 * bflo(o2.z), w0 * bfhi(o0.z) + w1 * bfhi(o1.z) + w2 * bfhi(o2.z));
                aw.w = pkbf(w0 * bflo(o0.w) + w1 * bflo(o1.w) + w2 * bflo(o2.w), w0 * bfhi(o0.w) + w1 * bfhi(o1.w) + w2 * bfhi(o2.w));
                *(u32x4*)(MIX + (size_t)t * 1024 + 512 + 8 * lane) = aw; }
        }
    }
    xcd_barrier(bar);

#if (PROBE_DUP >> 14) & 1
    {
        unsigned* CHK = (unsigned*)(ws + WS_CTL) + 2;
        for (int s_ = gw; s_ < 700 * 8; s_ += NGW) {
            const int si = s_ >> 3, h = s_ & 7;
            const int t = (si < 256) ? ((si >> 5) * SEQ + (si & 31) * ((si & 1) ? 1 : 9)) % T : (int)(((long)si * 7919) % T);
            const int ts = t & (SEQ - 1), b = t >> 11;
            float sc[3][3]; float mx = -1e30f;
#pragma unroll
            for (int br = 0; br < 3; ++br) { const int dil = (br == 0) ? 1 : (br == 1 ? 4 : 16);
#pragma unroll
                for (int c = 0; c < 3; ++c) { const int j = lane + 64 * c; float s = -1e30f;
                    if (j <= 128 && j <= ts / dil) { const int tk = b * SEQ + ts - j * dil; float acc = 0.f;
                        for (int d = 0; d < 64; ++d) acc += __uint_as_float((unsigned)Qb[(size_t)t * 512 + h * 64 + d] << 16) * __uint_as_float((unsigned)Kb[(size_t)tk * 512 + h * 64 + d] << 16);
                        s = acc; }
                    sc[br][c] = s; mx = fmaxf(mx, s); } }
#pragma unroll
            for (int o = 1; o < 64; o <<= 1) mx = fmaxf(mx, __shfl_xor(mx, o));
            float lsum = 0.f;
#pragma unroll
            for (int br = 0; br < 3; ++br)
#pragma unroll
                for (int c = 0; c < 3; ++c) { sc[br][c] = __builtin_amdgcn_exp2f(sc[br][c] - mx); lsum += sc[br][c]; }
            lsum = wave_sum(lsum);
            float ov = 0.f;
#pragma unroll
            for (int br = 0; br < 3; ++br) { const int dil = (br == 0) ? 1 : (br == 1 ? 4 : 16);
#pragma unroll
                for (int c = 0; c < 3; ++c)
                    for (int l2 = 0; l2 < 64; ++l2) { const int j = l2 + 64 * c; const float p = __shfl(sc[br][c], l2);
                        if (j <= 128 && j <= ts / dil) { const int tk = b * SEQ + ts - j * dil; ov += p * __uint_as_float((unsigned)Vb[(size_t)tk * 512 + h * 64 + lane] << 16); } } }
            ov /= lsum;
            const float got = __uint_as_float((unsigned)MIX[(size_t)t * 1024 + 512 + h * 64 + lane] << 16);
            bool bad = !(fabsf(got - ov) <= 0.004f + 0.02f * fabsf(ov));
            { const int ch = h * 64 + lane, grp = ch >> 7, w = 2 << grp; const int cnt = (ts + 1 < w) ? ts + 1 : w; float sm = 0.f;
              for (int j = 0; j < cnt; ++j) sm += __uint_as_float((unsigned)Ub[(size_t)(t - j) * 512 + ch] << 16);
              const float pv = sm / (float)cnt - __uint_as_float((unsigned)Ub[(size_t)t * 512 + ch] << 16);
              const float gp = __uint_as_float((unsigned)MIX[(size_t)t * 1024 + ch] << 16);
              bad = bad || !(fabsf(gp - pv) <= 0.004f + 0.02f * fabsf(pv)); }
            if (__any(bad) && lane == 0) atomicAdd(CHK, 1u);
        }
    }
    xcd_barrier(bar);
#endif
    {
        pg8::Gemm g{MIX, WoT, D}; pg8::StaticOrder S; S.init(T, D, D * 2, G, bx);
        pg8::EpiResF32 E{x, XMID};
        pg8::gemm_phase<pg8::EpiResF32, pg8::StaticOrder, true>(lds, g, S, E);
    }
    xcd_barrier(bar);
#if (PROBE_DUP >> 4) & 1
    {
        pg8::Gemm g{MIX, WoT, D}; pg8::StaticOrder S; S.init(T, D, D * 2, G, bx);
        pg8::EpiResF32 E{x, XMID};
        pg8::gemm_phase<pg8::EpiResF32, pg8::StaticOrder, true>(lds, g, S, E);
    }
    xcd_barrier(bar);
#endif

    {
        {
            const u32x4* wri = (const u32x4*)(ws + WS_TAB);
#pragma unroll
            for (int p = 0; p < 16; ++p) *(LAS u32x4*)(lds + (tid + 512 * p) * 16) = wri[tid + 512 * p];
        }
        LAS float* lgf = (LAS float*)(lds + LDS_G_OFF);
        lgf[tid] = g_ffn[tid]; lgf[tid + 512] = g_ffn[tid + 512];
        __syncthreads();
        LAS int* ltopi = (LAS int*)(lds + LDS_TOPI_OFF);
        unsigned char* XG8 = ws + WS_XS; float* RSTD = (float*)(ws + WS_RSTD);
        const int i16 = lane & 15, fq = lane >> 4, ti = i16 & 7;
        if (bx == 0 && wave == 0) *(u32x4*)(XG8 + (size_t)T * 1024 + 16 * lane) = (u32x4){0u, 0u, 0u, 0u};
        float brv[8];
#pragma unroll
        for (int j = 0; j < 8; ++j) brv[j] = b_router[16 * (j >> 2) + 4 * fq + (j & 3)];
        for (int blk_ = vcu; blk_ < (T / 64); blk_ += G) {
            const int blk = blk_ & 255;
            {
                const int tl = 8 * wave + ti, t = 64 * blk + tl;
                const float* xr = XMID + (size_t)t * 1024 + 8 * fq;
                f32x4 acc0 = (f32x4){0.f, 0.f, 0.f, 0.f}, acc1 = (f32x4){0.f, 0.f, 0.f, 0.f}; float ssq = 0.f;
#pragma unroll 8
                for (int ks = 0; ks < 32; ++ks) {
                    const f32x4 xa = __builtin_nontemporal_load((const f32x4*)(xr + 32 * ks)), xb = __builtin_nontemporal_load((const f32x4*)(xr + 32 * ks + 4));
                    const f32x4 ga = *(const LAS f32x4*)(lgf + 32 * ks + 8 * fq), gb = *(const LAS f32x4*)(lgf + 32 * ks + 8 * fq + 4);
                    ssq += (xa.x * xa.x + xa.y * xa.y) + (xa.z * xa.z + xa.w * xa.w) + (xb.x * xb.x + xb.y * xb.y) + (xb.z * xb.z + xb.w * xb.w);
                    const f32x4 ya = xa * ga, yb = xb * gb;
                    u32x4 H; H.x = pkbf(ya.x, ya.y); H.y = pkbf(ya.z, ya.w); H.z = pkbf(yb.x, yb.y); H.w = pkbf(yb.z, yb.w);
                    u32x4 L; L.x = pkbf(ya.x - bflo(H.x), ya.y - bfhi(H.x)); L.y = pkbf(ya.z - bflo(H.y), ya.w - bfhi(H.y)); L.z = pkbf(yb.x - bflo(H.z), yb.y - bfhi(H.z)); L.w = pkbf(yb.z - bflo(H.w), yb.w - bfhi(H.w));
                    u32x2 f8; f8.x = pk4f8(ya.x * XS_SCALE, ya.y * XS_SCALE, ya.z * XS_SCALE, ya.w * XS_SCALE); f8.y = pk4f8(yb.x * XS_SCALE, yb.y * XS_SCALE, yb.z * XS_SCALE, yb.w * XS_SCALE);
                    if (i16 < 8) *(u32x2*)(XG8 + (size_t)t * 1024 + 32 * ks + 8 * fq) = f8;
                    const bf16x8 xh = __builtin_bit_cast(bf16x8, H), xl = __builtin_bit_cast(bf16x8, L);
                    const int ch = 4 * ks + fq;
                    const bf16x8 wh0 = *(const LAS bf16x8*)(lds + 2048 * i16 + 16 * (ch ^ i16)), wl0 = *(const LAS bf16x8*)(lds + 65536 + 2048 * i16 + 16 * (ch ^ i16));
                    const bf16x8 wh1 = *(const LAS bf16x8*)(lds + 2048 * (16 + i16) + 16 * (ch ^ i16)), wl1 = *(const LAS bf16x8*)(lds + 65536 + 2048 * (16 + i16) + 16 * (ch ^ i16));
                    acc0 = __builtin_amdgcn_mfma_f32_16x16x32_bf16(wh0, xh, acc0, 0, 0, 0); acc1 = __builtin_amdgcn_mfma_f32_16x16x32_bf16(wh1, xh, acc1, 0, 0, 0);
                    acc0 = __builtin_amdgcn_mfma_f32_16x16x32_bf16(wl0, xh, acc0, 0, 0, 0); acc1 = __builtin_amdgcn_mfma_f32_16x16x32_bf16(wl1, xh, acc1, 0, 0, 0);
                    acc0 = __builtin_amdgcn_mfma_f32_16x16x32_bf16(wh0, xl, acc0, 0, 0, 0); acc1 = __builtin_amdgcn_mfma_f32_16x16x32_bf16(wh1, xl, acc1, 0, 0, 0);
                }
                ssq += __shfl_xor(ssq, 16); ssq += __shfl_xor(ssq, 32);
                const float rstd = 1.0f / sqrtf(ssq * (1.f / D) + EPS);
                float my[8];
#pragma unroll
                for (int r = 0; r < 4; ++r) { my[r] = acc0[r] * rstd + brv[r]; my[4 + r] = acc1[r] * rstd + brv[4 + r]; }
                float lg[32];
#pragma unroll
                for (int f = 0; f < 4; ++f)
#pragma unroll
                    for (int j = 0; j < 8; ++j) lg[16 * (j >> 2) + 4 * f + (j & 3)] = __shfl(my[j], i16 + 16 * f);
                unsigned taken = 0u; float tv[4]; int tix[4];
#pragma unroll
                for (int r = 0; r < 4; ++r) { float best = -3.0e38f; int bi = 0;
#pragma unroll
                    for (int e = 0; e < 32; ++e) { const bool ok = !((taken >> e) & 1u) && (lg[e] > best); best = ok ? lg[e] : best; bi = ok ? e : bi; }
                    taken |= 1u << bi; tv[r] = best; tix[r] = bi; }
                const float e1 = __expf(tv[1] - tv[0]), e2 = __expf(tv[2] - tv[0]), e3 = __expf(tv[3] - tv[0]); const float is = 1.0f / (1.0f + e1 + e2 + e3);
                if (lane < 8) { *(int4*)(TOPI + (size_t)t * 4) = make_int4(tix[0], tix[1], tix[2], tix[3]); *(f32x4*)(GATE + (size_t)t * 4) = (f32x4){is, e1 * is, e2 * is, e3 * is};
                    RSTD[t] = rstd;
                    ltopi[tl * 4 + 0] = tix[0]; ltopi[tl * 4 + 1] = tix[1]; ltopi[tl * 4 + 2] = tix[2]; ltopi[tl * 4 + 3] = tix[3]; }
            }
            __syncthreads();
            if (wave == 0) {
                const int e0 = ltopi[lane * 4 + 0], e1 = ltopi[lane * 4 + 1], e2 = ltopi[lane * 4 + 2], e3 = ltopi[lane * 4 + 3];
                int r0 = 0, r1 = 0, r2 = 0, r3 = 0, mycnt = 0; const unsigned long long below = (1ull << lane) - 1ull;
                for (int e = 0; e < 32; ++e) { const bool hit = (e0 == e) | (e1 == e) | (e2 == e) | (e3 == e); const unsigned long long mk = __ballot(hit); const int rk = __popcll(mk & below);
                    if (e0 == e) r0 = rk; if (e1 == e) r1 = rk; if (e2 == e) r2 = rk; if (e3 == e) r3 = rk; if (lane == e) mycnt = __popcll(mk); }
                int base = 0; if (lane < 32) base = (int)__hip_atomic_fetch_add(CNT + lane, (unsigned)mycnt, __ATOMIC_RELAXED, __HIP_MEMORY_SCOPE_AGENT);
                r0 += __shfl(base, e0); r1 += __shfl(base, e1); r2 += __shfl(base, e2); r3 += __shfl(base, e3);
                const int tt = 64 * blk + lane;
                *(int4*)(LRANK + (size_t)tt * 4) = make_int4(r0, r1, r2, r3);
                INV[(size_t)e0 * T + r0] = tt; INV[(size_t)e1 * T + r1] = tt; INV[(size_t)e2 * T + r2] = tt; INV[(size_t)e3 * T + r3] = tt;
            }
            __syncthreads();
        }
    }
    xcd_barrier(bar);

    {
        LAS int* ltab = (LAS int*)(lds + LDS_TAB_OFF); LAS int* lnmt = (LAS int*)(lds + LDS_NMT_OFF);
        LAS int* lcnt = (LAS int*)(lds + LDS_P6_OFF), * lO = lcnt + 32;
        LAS int* lrow = (LAS int*)(lds + LDS_ROWT_OFF); LAS float* lrs = (LAS float*)(lds + LDS_RSTB_OFF);
        if (tid < 32) lcnt[tid] = (int)__hip_atomic_load(CNT + tid, __ATOMIC_RELAXED, __HIP_MEMORY_SCOPE_AGENT);
        __syncthreads();
        if (tid == 0) { int off = 0; for (int e = 0; e < 32; ++e) { lO[e] = off; off += ((lcnt[e] + 255) >> 8) << 8; } lO[32] = off; lnmt[0] = off >> 8; }
        __syncthreads();
        const int nmt = rfl(lnmt[0]);
        for (int mt = tid; mt < nmt && mt < 384; mt += NWAVES * 64) { int e = 0; for (int q = 1; q < 32; ++q) e += (lO[q] <= mt * 256) ? 1 : 0; ltab[mt] = e; }
        __syncthreads();
        {
            pg8::GroupedOrder S0; S0.init(nmt, 2048, D, G, bx, ltab, (size_t)2048 * 1024); pg8::Unit u0;
            const float* RSTD = (const float*)(ws + WS_RSTD);
            for (int i = 0; i < MAX_UNITS && S0.next(i, u0); ++i) if (tid < 256) {
                const int e = u0.e, rk = u0.pm * 256 - lO[e] + tid; const bool valid = rk < lcnt[e];
                const int tok = valid ? INV[(size_t)e * T + rk] : T;
                lrow[i * 256 + tid] = tok * 1024; lrs[i * 256 + tid] = valid ? RSTD[tok] : 0.f; }
        }
        __syncthreads();
        {
            pg8::Gemm8 g{XS, WguT, D}; pg8::GroupedOrder S; S.init(nmt, 2048, D, G, bx, ltab, (size_t)2048 * 1024);
            pg8::EpiSwiGLU E{ACT, b_gu, lrs};
            pg8::gemm_phase_f8<pg8::EpiSwiGLU, pg8::GroupedOrder, true, true>(lds, g, S, E, lrow);
        }
        xcd_barrier(bar);
        {
            pg8::Gemm8 g{ACT, WdT, DE}; pg8::GroupedOrder S; S.init(nmt, 1024, DE, G, bx, ltab, (size_t)1024 * 1024);
            pg8::EpiBiasBf16 E{Yb, b_down};
            pg8::gemm_phase_f8<pg8::EpiBiasBf16, pg8::GroupedOrder, true>(lds, g, S, E);
        }
    }
    xcd_barrier(bar);

    {
        unsigned bad = __hip_atomic_load((unsigned*)(ws + WS_CTL) + CW_BAR + XB_TMO, __ATOMIC_RELAXED, __HIP_MEMORY_SCOPE_AGENT);
#if (PROBE_DUP >> 14) & 1
        bad |= __hip_atomic_load((unsigned*)(ws + WS_CTL) + 2, __ATOMIC_RELAXED, __HIP_MEMORY_SCOPE_AGENT);
#endif
        LAS int* lO9 = (LAS int*)(lds + LDS_P6_OFF) + 32;
        __syncthreads();
        if (tid == 0) { int off = 0; for (int e = 0; e < 32; ++e) { lO9[e] = off; off += (((int)__hip_atomic_load(CNT + e, __ATOMIC_RELAXED, __HIP_MEMORY_SCOPE_AGENT) + 255) >> 8) << 8; } }
        __syncthreads();
        for (int t_ = gw; t_ < DUPN(9) * T; t_ += NGW) {
            const int t = t_ & (T - 1);
            const int4 ee = *(const int4*)(TOPI + (size_t)t * 4), rk = *(const int4*)(LRANK + (size_t)t * 4);
            const int4 ps = make_int4(lO9[ee.x] + rk.x, lO9[ee.y] + rk.y, lO9[ee.z] + rk.z, lO9[ee.w] + rk.w); const f32x4 gt = *(const f32x4*)(GATE + (size_t)t * 4);
            const f32x4* xr = (const f32x4*)(XMID + (size_t)t * 1024) + lane; const f32x4* gr = (const f32x4*)g_final + lane;
            const unsigned* y0 = (const unsigned*)(Yb + (size_t)ps.x * 1024) + lane; const unsigned* y1 = (const unsigned*)(Yb + (size_t)ps.y * 1024) + lane;
            const unsigned* y2 = (const unsigned*)(Yb + (size_t)ps.z * 1024) + lane; const unsigned* y3 = (const unsigned*)(Yb + (size_t)ps.w * 1024) + lane;
            const f32x4 gs = gt * (1.0f / Y_SCALE);
            f32x4 v[4]; float s = 0.f;
#pragma unroll
            for (int j = 0; j < 4; ++j) { v[j] = __builtin_nontemporal_load(xr + 64 * j); const int a = (int)__builtin_nontemporal_load(y0 + 64 * j), b = (int)__builtin_nontemporal_load(y1 + 64 * j), c = (int)__builtin_nontemporal_load(y2 + 64 * j), d = (int)__builtin_nontemporal_load(y3 + 64 * j);
                const f32x2 al = __builtin_amdgcn_cvt_pk_f32_fp8(a, false), ah = __builtin_amdgcn_cvt_pk_f32_fp8(a, true), bl = __builtin_amdgcn_cvt_pk_f32_fp8(b, false), bh = __builtin_amdgcn_cvt_pk_f32_fp8(b, true);
                const f32x2 cl = __builtin_amdgcn_cvt_pk_f32_fp8(c, false), chh = __builtin_amdgcn_cvt_pk_f32_fp8(c, true), dl = __builtin_amdgcn_cvt_pk_f32_fp8(d, false), dh = __builtin_amdgcn_cvt_pk_f32_fp8(d, true);
                v[j].x += gs.x * al.x + gs.y * bl.x + gs.z * cl.x + gs.w * dl.x;
                v[j].y += gs.x * al.y + gs.y * bl.y + gs.z * cl.y + gs.w * dl.y;
                v[j].z += gs.x * ah.x + gs.y * bh.x + gs.z * chh.x + gs.w * dh.x;
                v[j].w += gs.x * ah.y + gs.y * bh.y + gs.z * chh.y + gs.w * dh.y;
                s += (v[j].x * v[j].x + v[j].y * v[j].y) + (v[j].z * v[j].z + v[j].w * v[j].w); }
            float rstd = 1.0f / sqrtf(wave_sum(s) * (1.f / D) + EPS);
            if (bad) rstd = __builtin_nanf("");
            f32x4* orow = (f32x4*)(out + (size_t)t * 1024) + lane;
#pragma unroll
            for (int j = 0; j < 4; ++j) { const f32x4 gv = gr[64 * j]; __builtin_nontemporal_store(v[j] * rstd * gv, orow + 64 * j); }
        }
    }
}

extern "C" void kernel_launch(void* const* d_in, const int* in_sizes, int n_in, void* d_out, int out_size, void* d_ws, size_t ws_size, hipStream_t stream) {
    static int grid = 0;
    if (grid == 0) {
        if (n_in != 14 || in_sizes[0] != T * D || out_size != T * D || ws_size < WS_END) { fprintf(stderr, "kernel_launch: unexpected shapes (n_in %d, in0 %d, out %d, ws %zu)\n", n_in, n_in > 0 ? in_sizes[0] : -1, out_size, ws_size); grid = -1; return; }
        int dev = 0, cus = 0, per_cu = 0;
        if (hipGetDevice(&dev) != hipSuccess || hipDeviceGetAttribute(&cus, hipDeviceAttributeMultiprocessorCount, dev) != hipSuccess) { grid = -1; return; }
        if (hipFuncSetAttribute((const void*)mega_fwd, hipFuncAttributeMaxDynamicSharedMemorySize, LDS_BYTES) != hipSuccess) { fprintf(stderr, "kernel_launch: hipFuncSetAttribute failed\n"); grid = -1; return; }
        if (hipOccupancyMaxActiveBlocksPerMultiprocessor(&per_cu, (const void*)mega_fwd, NWAVES * 64, LDS_BYTES) != hipSuccess || per_cu < 1)
            fprintf(stderr, "kernel_launch: note: occupancy query reports %d workgroups per CU\n", per_cu);
        (void)hipGetLastError();
        grid = cus;
    }
    if (grid < 0) return;
    if (hipMemsetAsync((char*)d_ws + WS_CTL, 0, CTL_ZERO_BYTES, stream) != hipSuccess) return;
    Args a{};
    for (int i = 0; i < 14; ++i) a.in[i] = (const float*)d_in[i];
    a.out = (float*)d_out; a.ws = (unsigned char*)d_ws;
    hipLaunchKernelGGL(mega_fwd, dim3(grid), dim3(NWAVES * 64), LDS_BYTES, stream, a);
}
```

```cpp
#include <hip/hip_runtime.h>
#include <cstdio>
#include <cstdint>
#ifndef PROBE_DUP
#define PROBE_DUP 0
#endif
#define DUPN(k) (((PROBE_DUP >> (k)) & 1) ? 2 : 1)

#define GAS __attribute__((address_space(1)))
#define LAS __attribute__((address_space(3)))
typedef unsigned short bf16_t;
typedef short bf16x8 __attribute__((ext_vector_type(8)));
typedef float f32x4 __attribute__((ext_vector_type(4)));
typedef float f32x2 __attribute__((ext_vector_type(2)));
typedef unsigned u32x4 __attribute__((ext_vector_type(4)));
typedef unsigned u32x2 __attribute__((ext_vector_type(2)));
typedef __bf16 bf16x2_t __attribute__((ext_vector_type(2)));
typedef short v4i16_t __attribute__((ext_vector_type(4)));

__device__ __forceinline__ unsigned pkbf(float lo, float hi) { f32x2 v = {lo, hi}; bf16x2_t b = __builtin_convertvector(v, bf16x2_t); return __builtin_bit_cast(unsigned, b); }
__device__ __forceinline__ float bflo(unsigned w) { return __uint_as_float(w << 16); }
__device__ __forceinline__ float bfhi(unsigned w) { return __uint_as_float(w & 0xffff0000u); }
__device__ __forceinline__ int rfl(int v) { return __builtin_amdgcn_readfirstlane(v); }

constexpr int T = 16384, D = 1024, SEQ = 2048, NH = 8, HD = 64, DP = 512, DA = 512, NE = 32, TOPK = 4, DE = 1024;
constexpr float EPS = 1e-5f;
constexpr int MAXROWS = 73728;
constexpr float QSCALE = 0.125f * 1.4426950408889634f;

constexpr float W_SCALE = 64.0f, XS_SCALE = 16.0f, ACT_SCALE = 4.0f, Y_SCALE = 16.0f;
__device__ __forceinline__ float clamp448(float v) { return __builtin_amdgcn_fmed3f(v, -448.0f, 448.0f); }
__device__ __forceinline__ unsigned pk4f8_nc(float a, float b, float c, float d) {
    int w = __builtin_amdgcn_cvt_pk_fp8_f32(a, b, 0, false); w = __builtin_amdgcn_cvt_pk_fp8_f32(c, d, w, true); return (unsigned)w; }
__device__ __forceinline__ unsigned pk4f8(float a, float b, float c, float d) {
    int w = __builtin_amdgcn_cvt_pk_fp8_f32(clamp448(a), clamp448(b), 0, false);
    w = __builtin_amdgcn_cvt_pk_fp8_f32(clamp448(c), clamp448(d), w, true);
    return (unsigned)w;
}
typedef int v8i32 __attribute__((ext_vector_type(8)));
namespace pg8 {
constexpr int BM = 256, BK = 64, HALF = 128, HTB = HALF * BK * 2, STAGE_BYTES = 8 * HTB, NXCD = 8, WGM = 8;
__host__ __device__ __forceinline__ int lds_byte(int r, int c) { const int st = (r >> 4) * 2 + (c >> 5), rr = r & 15, cc = c & 31, ob = rr * 64 + cc * 2; return st * 1024 + (ob ^ (((ob >> 9) & 1) << 5)); }
__host__ __device__ __forceinline__ void stage_rc(int b, int& R, int& C) { const int st = b / 1024, sb = b % 1024, swz = sb ^ (((sb >> 9) & 1) << 5); R = (st >> 1) * 16 + swz / 64; C = (st & 1) * 32 + (swz % 64) / 2; }
__host__ __device__ __forceinline__ int perm32(int rho) { const int n = rho >> 4, i = rho & 15; return 8 * (i >> 2) + 4 * n + (i & 3); }

struct Unit { int pm, pn, e, ui; };
struct Gemm { const bf16_t* A; const bf16_t* Bt; int K; };

struct StaticOrder {
    int nM, nN, nwg, G, c, rb;
    __device__ void init(int M, int N, int rb_, int G_, int c_) { nM = M / BM; nN = N / BM; nwg = nM * nN; G = G_; c = c_; rb = rb_; }
    __device__ __forceinline__ bool next(int i, Unit& u) const {
        const long L = (long)i * G + c; if (L >= nwg) return false;
        int wgid = (int)L; { const int q = nwg / NXCD, r = nwg % NXCD, xcd = wgid % NXCD, off = wgid / NXCD; wgid = (xcd < r ? xcd * (q + 1) : r * (q + 1) + (xcd - r) * q) + off; }
        const int nig = WGM * nN, gid = wgid / nig, fm = gid * WGM, gsz = (nM - fm) < WGM ? (nM - fm) : WGM;
        u.pm = fm + ((wgid % nig) % gsz); u.pn = (wgid % nig) / gsz; u.e = 0; u.ui = i; return true;
    }
    __device__ __forceinline__ size_t a_off(const Unit& u) const { return (size_t)u.pm * BM * rb; }
    __device__ __forceinline__ size_t b_off(const Unit& u) const { return (size_t)u.pn * BM * rb; }
};
struct GroupedOrder {
    int nM, nN, nwg, G, c, rb; const LAS int* tab; size_t bexp;
    __device__ void init(int nM_, int N, int rb_, int G_, int c_, const LAS int* tab_, size_t bexp_) { nM = nM_; nN = N / BM; nwg = nM * nN; G = G_; c = c_; rb = rb_; tab = tab_; bexp = bexp_; }
    __device__ __forceinline__ bool next(int i, Unit& u) const {
        const long L = (long)i * G + c; if (L >= nwg) return false;
        int wgid = (int)L; { const int q = nwg / NXCD, r = nwg % NXCD, xcd = wgid % NXCD, off = wgid / NXCD; wgid = (xcd < r ? xcd * (q + 1) : r * (q + 1) + (xcd - r) * q) + off; }
        const int nig = WGM * nN, gid = wgid / nig, fm = gid * WGM, gsz = (nM - fm) < WGM ? (nM - fm) : WGM;
        u.pm = fm + ((wgid % nig) % gsz); u.pn = (wgid % nig) / gsz; u.e = __builtin_amdgcn_readfirstlane(tab[u.pm]); u.ui = i; return true;
    }
    __device__ __forceinline__ size_t a_off(const Unit& u) const { return (size_t)u.pm * BM * rb; }
    __device__ __forceinline__ size_t b_off(const Unit& u) const { return (size_t)u.e * bexp + (size_t)u.pn * BM * rb; }
};

struct EpiQKV {
    static constexpr bool PERM = true;
    bf16_t* O; size_t stride; float qscale;
    __device__ __forceinline__ void operator()(const f32x4 (&acc)[2][2][4][2], const Unit& u, int wr, int wc, int fr, int fq) const {
        const int t = u.pn >> 1; bf16_t* base = O + (size_t)t * stride; const float sc = (t == 1) ? qscale : 1.f;
        const int row0 = u.pm * BM + wr * 64 + fr, col0 = (u.pn & 1) * BM + wc * 32 + 8 * fq;
#pragma unroll
        for (int ai = 0; ai < 2; ++ai)
#pragma unroll
            for (int m = 0; m < 4; ++m) { bf16_t* rowp = base + (size_t)(row0 + ai * HALF + m * 16) * 512 + col0;
#pragma unroll
                for (int bj = 0; bj < 2; ++bj) { const f32x4 v0 = acc[ai][bj][m][0] * sc, v1 = acc[ai][bj][m][1] * sc;
                    u32x4 w; w.x = pkbf(v0[0], v0[1]); w.y = pkbf(v0[2], v0[3]); w.z = pkbf(v1[0], v1[1]); w.w = pkbf(v1[2], v1[3]);
                    *(u32x4*)(rowp + bj * HALF) = w; } }
    }
};
struct EpiResF32 {
    static constexpr bool PERM = false;
    const float* base; float* out;
    __device__ __forceinline__ void operator()(const f32x4 (&acc)[2][2][4][2], const Unit& u, int wr, int wc, int fr, int fq) const {
        const int col0 = u.pn * BM + wc * 32 + 4 * fq;
#pragma unroll
        for (int ai = 0; ai < 2; ++ai)
#pragma unroll
            for (int m = 0; m < 4; ++m) { const size_t off = (size_t)(u.pm * BM + ai * HALF + wr * 64 + m * 16 + fr) * 1024 + col0;
#pragma unroll
                for (int bj = 0; bj < 2; ++bj)
#pragma unroll
                    for (int n = 0; n < 2; ++n) { const f32x4 bs = __builtin_nontemporal_load((const f32x4*)(base + off + bj * HALF + n * 16)); *(f32x4*)(out + off + bj * HALF + n * 16) = bs + acc[ai][bj][m][n]; } }
    }
};
struct EpiSwiGLU {
    static constexpr bool PERM = true;
    unsigned char* O; const float* bgu; const LAS float* rs;
    __device__ __forceinline__ void operator()(const f32x4 (&acc)[2][2][4][2], const Unit& u, int wr, int wc, int fr, int fq) const {
        const int row0 = u.pm * BM + wr * 64 + fr, jc0 = wc * 32 + 8 * fq;
        const float* bg = bgu + (size_t)u.e * 2048 + u.pn * 128 + jc0; const float* bl = bg + 1024;
        f32x4 bgv[2], blv[2];
#pragma unroll
        for (int n = 0; n < 2; ++n) { bgv[n] = *(const f32x4*)(bg + 4 * n); blv[n] = *(const f32x4*)(bl + 4 * n); }
        const int odd = fq & 1;
        unsigned char* cbase = O + (size_t)(row0 + odd * 16) * 1024 + u.pn * 128 + wc * 32 + 8 * (fq - odd);
#pragma unroll
        for (int ai = 0; ai < 2; ++ai)
#pragma unroll
            for (int mp = 0; mp < 2; ++mp) {
                u32x2 w2[2];
#pragma unroll
                for (int mm = 0; mm < 2; ++mm) { const int m = 2 * mp + mm;
                    const float rsc = rs[u.ui * 256 + wr * 64 + fr + ai * HALF + m * 16] * (1.0f / (W_SCALE * XS_SCALE));
                    float a[8];
#pragma unroll
                    for (int n = 0; n < 2; ++n) { const f32x4 g4 = acc[ai][0][m][n] * rsc + bgv[n], l4 = acc[ai][1][m][n] * rsc + blv[n];
#pragma unroll
                        for (int j = 0; j < 4; ++j) { const float gate = fminf(g4[j], 7.0f); const float lin = __builtin_amdgcn_fmed3f(l4[j], -7.0f, 7.0f);
                            const float sg = __builtin_amdgcn_rcpf(1.0f + __builtin_amdgcn_exp2f(gate * (-1.702f * 1.4426950408889634f)));
                            a[4 * n + j] = (gate * sg) * (lin * ACT_SCALE + ACT_SCALE); } }
                    w2[mm].x = pk4f8_nc(a[0], a[1], a[2], a[3]); w2[mm].y = pk4f8_nc(a[4], a[5], a[6], a[7]); }
                const auto sx = __builtin_amdgcn_permlane16_swap(w2[0].x, w2[1].x, false, false), sy = __builtin_amdgcn_permlane16_swap(w2[0].y, w2[1].y, false, false);
                u32x4 o; o.x = sx[0]; o.y = sy[0]; o.z = sx[1]; o.w = sy[1];
                *(u32x4*)(cbase + (size_t)(ai * HALF + mp * 32) * 1024) = o; }
    }
};
struct EpiBiasBf16 {
    static constexpr bool PERM = true;
    unsigned char* O; const float* bias;
    __device__ __forceinline__ void operator()(const f32x4 (&acc)[2][2][4][2], const Unit& u, int wr, int wc, int fr, int fq) const {
        const int row0 = u.pm * BM + wr * 64 + fr, col0 = u.pn * BM + wc * 32 + 8 * fq;
        const float* bp = bias + (size_t)u.e * 1024 + col0;
        f32x4 bv[2][2];
#pragma unroll
        for (int bj = 0; bj < 2; ++bj)
#pragma unroll
            for (int n = 0; n < 2; ++n) bv[bj][n] = *(const f32x4*)(bp + bj * HALF + 4 * n) * Y_SCALE;
        const int odd = fq & 1;
        unsigned char* cbase = O + (size_t)(row0 + odd * 16) * 1024 + u.pn * BM + wc * 32 + 8 * (fq - odd);
#pragma unroll
        for (int ai = 0; ai < 2; ++ai)
#pragma unroll
            for (int mp = 0; mp < 2; ++mp)
#pragma unroll
                for (int bj = 0; bj < 2; ++bj) {
                    u32x2 w2[2];
#pragma unroll
                    for (int mm = 0; mm < 2; ++mm) { const int m = 2 * mp + mm;
                        const f32x4 v0 = acc[ai][bj][m][0] * (Y_SCALE / (W_SCALE * ACT_SCALE)) + bv[bj][0], v1 = acc[ai][bj][m][1] * (Y_SCALE / (W_SCALE * ACT_SCALE)) + bv[bj][1];
                        w2[mm].x = pk4f8(v0[0], v0[1], v0[2], v0[3]); w2[mm].y = pk4f8(v1[0], v1[1], v1[2], v1[3]); }
                    const auto sx = __builtin_amdgcn_permlane16_swap(w2[0].x, w2[1].x, false, false), sy = __builtin_amdgcn_permlane16_swap(w2[0].y, w2[1].y, false, false);
                    u32x4 o; o.x = sx[0]; o.y = sy[0]; o.z = sx[1]; o.w = sy[1];
                    *(u32x4*)(cbase + (size_t)(ai * HALF + mp * 32) * 1024 + bj * HALF) = o; }
    }
};

template <class Epi, class Sched, bool ALIGN_EPI>
__device__ __forceinline__ void gemm_phase(LAS unsigned char* lds, const Gemm g, const Sched& S, const Epi& E) {
    const int tid = threadIdx.x, wid = __builtin_amdgcn_readfirstlane(tid >> 6), lane = tid & 63, wr = wid >> 2, wc = wid & 3, fr = lane & 15, fq = lane >> 4;
    const int K = g.K, nt = K / BK;
    unsigned voffA, voffB;
    { int R, C; stage_rc(tid * 16, R, C); const int Rb = Epi::PERM ? ((R & ~31) + perm32(R & 31)) : R;
        voffA = (unsigned)(R * K + C) * 2u; voffB = (unsigned)(Rb * K + C) * 2u; }
    const size_t pstep = (size_t)64 * K * 2;
    const size_t kstep = (size_t)(BK * 2);
    const size_t hstep = (size_t)HALF * K * 2;
    const unsigned ldsw = (unsigned)wid * 1024u;
    const int aoff = lds_byte(wr * 64 + fr, fq * 8), boff = lds_byte(wc * 32 + fr, fq * 8);
#define PG8_SA(b, h) (((b) * 2 + (h)) * HTB)
#define PG8_SB(b, h) ((4 + (b) * 2 + (h)) * HTB)
#define PG8_STAGE(bufoff, gbase, voff) do { _Pragma("unroll") for (int _i = 0; _i < 2; ++_i) \
        __builtin_amdgcn_global_load_lds((const unsigned*)((const char*)(gbase) + _i * pstep + (voff)), (LAS unsigned*)(lds + (bufoff) + ldsw + _i * 8192), 16, 0, 0); } while (0)
#define PG8_LDA(dst, b, h) do { _Pragma("unroll") for (int m = 0; m < 4; ++m) _Pragma("unroll") for (int k = 0; k < 2; ++k) dst[m][k] = *(const LAS bf16x8*)(lds + PG8_SA(b, h) + aoff + m * 2048 + k * 1024); } while (0)
#define PG8_LDB(dst, b, h) do { _Pragma("unroll") for (int n = 0; n < 2; ++n) _Pragma("unroll") for (int k = 0; k < 2; ++k) dst[n][k] = *(const LAS bf16x8*)(lds + PG8_SB(b, h) + boff + n * 2048 + k * 1024); } while (0)
#define PG8_MMA(ai, bj, At, Bt) do { __builtin_amdgcn_s_setprio(1); _Pragma("unroll") for (int m = 0; m < 4; ++m) _Pragma("unroll") for (int n = 0; n < 2; ++n) _Pragma("unroll") for (int k = 0; k < 2; ++k) \
        acc[ai][bj][m][n] = __builtin_amdgcn_mfma_f32_16x16x32_bf16(Bt[n][k], At[m][k], acc[ai][bj][m][n], 0, 0, 0); __builtin_amdgcn_s_setprio(0); } while (0)
#define PG8_WAIT_V(n) asm volatile("s_waitcnt vmcnt(" #n ")" ::: "memory")
#define PG8_WAIT_L(n) asm volatile("s_waitcnt lgkmcnt(" #n ")" ::: "memory")
#define PG8_BAR __builtin_amdgcn_s_barrier()
#define PG8_SCHED __builtin_amdgcn_sched_barrier(0)
    Unit cur, nxt; int ui = 0;
    if (!S.next(0, cur)) return;
    f32x4 acc[2][2][4][2];
#pragma unroll
    for (int a = 0; a < 2; ++a)
#pragma unroll
        for (int b = 0; b < 2; ++b)
#pragma unroll
            for (int m = 0; m < 4; ++m)
#pragma unroll
                for (int n = 0; n < 2; ++n) acc[a][b][m][n] = (f32x4){0.f, 0.f, 0.f, 0.f};
    bf16x8 At[4][2], B0[2][2], B1[2][2];
    const char* cA = (const char*)g.A + S.a_off(cur); const char* cB = (const char*)g.Bt + S.b_off(cur);
    PG8_STAGE(PG8_SB(0, 0), cB, voffB); PG8_STAGE(PG8_SB(0, 1), cB + hstep, voffB); PG8_STAGE(PG8_SA(0, 0), cA, voffA); PG8_STAGE(PG8_SA(0, 1), cA + hstep, voffA);
    if (wr == 1) PG8_BAR;
    PG8_WAIT_V(2); PG8_BAR;
    PG8_STAGE(PG8_SB(1, 0), cB + kstep, voffB); PG8_STAGE(PG8_SA(1, 0), cA + kstep, voffA); PG8_STAGE(PG8_SB(1, 1), cB + hstep + kstep, voffB);
    PG8_WAIT_V(6); PG8_BAR;
    for (;;) {
        const bool has_next = S.next(ui + 1, nxt);
        const char* nA = has_next ? (const char*)g.A + S.a_off(nxt) : cA; const char* nB = has_next ? (const char*)g.Bt + S.b_off(nxt) : cB;
#pragma nounroll
        for (int t = 0; t < nt; t += 2) {
            const bool last = (t == nt - 2);
            const char* a1 = cA + (size_t)(t + 1) * kstep;
            const char* a2 = last ? nA : cA + (size_t)(t + 2) * kstep; const char* b2 = last ? nB : cB + (size_t)(t + 2) * kstep;
            const char* a3 = a2 + kstep; const char* b3 = b2 + kstep;
            PG8_LDB(B0, 0, 0); PG8_LDB(B1, 0, 1); PG8_SCHED; PG8_LDA(At, 0, 0); PG8_STAGE(PG8_SA(1, 1), a1 + hstep, voffA);
            PG8_WAIT_V(8); PG8_WAIT_L(0); PG8_BAR; PG8_MMA(0, 0, At, B0); PG8_MMA(0, 1, At, B1); PG8_BAR; PG8_SCHED;
            PG8_LDA(At, 0, 1); PG8_STAGE(PG8_SB(0, 0), b2, voffB); PG8_STAGE(PG8_SB(0, 1), b2 + hstep, voffB); PG8_STAGE(PG8_SA(0, 0), a2, voffA);
            PG8_WAIT_V(8); PG8_WAIT_L(0); PG8_BAR; PG8_MMA(1, 0, At, B0); PG8_MMA(1, 1, At, B1); PG8_BAR; PG8_SCHED;
            PG8_LDB(B0, 1, 0); PG8_LDB(B1, 1, 1); PG8_SCHED; PG8_LDA(At, 1, 0); PG8_STAGE(PG8_SA(0, 1), a2 + hstep, voffA);
            PG8_WAIT_V(8); PG8_WAIT_L(0); PG8_BAR; PG8_MMA(0, 0, At, B0); PG8_MMA(0, 1, At, B1); PG8_BAR; PG8_SCHED;
            PG8_LDA(At, 1, 1); PG8_STAGE(PG8_SB(1, 0), b3, voffB); PG8_STAGE(PG8_SB(1, 1), b3 + hstep, voffB); PG8_STAGE(PG8_SA(1, 0), a3, voffA);
            PG8_WAIT_V(8); PG8_WAIT_L(0); PG8_BAR; PG8_MMA(1, 0, At, B0); PG8_MMA(1, 1, At, B1); PG8_BAR; PG8_SCHED;
        }
        if constexpr (ALIGN_EPI) { if (wr == 0) PG8_BAR; }
        E(acc, cur, wr, wc, fr, fq);
        if (!has_next) break;
#pragma unroll
        for (int a = 0; a < 2; ++a)
#pragma unroll
            for (int b = 0; b < 2; ++b)
#pragma unroll
                for (int m = 0; m < 4; ++m)
#pragma unroll
                    for (int n = 0; n < 2; ++n) acc[a][b][m][n] = (f32x4){0.f, 0.f, 0.f, 0.f};
        cur = nxt; cA = nA; cB = nB; ++ui;
        if constexpr (ALIGN_EPI) { if (wr == 1) PG8_BAR; }
    }
    PG8_WAIT_V(0);
    if constexpr (!ALIGN_EPI) { if (wr == 0) PG8_BAR; }
    PG8_BAR;
#undef PG8_SA
#undef PG8_SB
#undef PG8_STAGE
#undef PG8_LDA
#undef PG8_LDB
#undef PG8_MMA
#undef PG8_WAIT_V
#undef PG8_WAIT_L
#undef PG8_BAR
#undef PG8_SCHED
}
__host__ __device__ __forceinline__ int f8swz(int r) { return ((r >> 2) & 1) | (((r >> 1) & 1) << 2); }
struct Gemm8 { const unsigned char* A; const unsigned char* Bt; int Kb; };
template <class Epi, class Sched, bool ALIGN_EPI, bool GATHER = false>
__device__ __forceinline__ void gemm_phase_f8(LAS unsigned char* lds, const Gemm8 g, const Sched& S, const Epi& E, const LAS int* rowtab = nullptr) {
    const int tid = threadIdx.x, wid = __builtin_amdgcn_readfirstlane(tid >> 6), lane = tid & 63, wr = wid >> 2, wc = wid & 3, fr = lane & 15, fq = lane >> 4;
    const int Kb = g.Kb, nt = Kb / 128;
    unsigned voffA, voffB;
    { const int b = tid * 16, R = b >> 7, c = ((b >> 4) & 7) ^ f8swz(R & 15); const int Rb = Epi::PERM ? ((R & ~31) + perm32(R & 31)) : R;
        voffA = (unsigned)(R * Kb + 16 * c); voffB = (unsigned)(Rb * Kb + 16 * c); }
    const size_t pstep = (size_t)64 * Kb;
    const size_t kstep = 128;
    const int gc16 = 16 * ((tid & 7) ^ f8swz((tid >> 3) & 15));
    unsigned offC[2][2], offN[2][2];
#define PG8_ROWOFF(dst, uidx) do { _Pragma("unroll") for (int _h = 0; _h < 2; ++_h) _Pragma("unroll") for (int _i = 0; _i < 2; ++_i) dst[_h][_i] = (unsigned)(rowtab[(uidx) * 256 + _h * 128 + _i * 64 + (tid >> 3)] + gc16); } while (0)
#define PG8_STAGE_G(bufoff, kbyte, offs, h) do { _Pragma("unroll") for (int _i = 0; _i < 2; ++_i) \
        __builtin_amdgcn_global_load_lds((const unsigned*)((const char*)g.A + (kbyte) + (offs)[h][_i]), (LAS unsigned*)(lds + (bufoff) + ldsw + _i * 8192), 16, 0, 0); } while (0)
#define PG8_STAGE_A(b, h, ptr, kbyte, offs) do { if constexpr (GATHER) PG8_STAGE_G(PG8_SA(b, h), kbyte, offs, h); else PG8_STAGE(PG8_SA(b, h), (ptr) + (h) * hstep, voffA); } while (0)
    const size_t hstep = (size_t)HALF * Kb;
    const unsigned ldsw = (unsigned)wid * 1024u;
    LAS unsigned char* ab0 = lds + 128 * (wr * 64 + fr) + 16 * ((2 * fq) ^ f8swz(fr)); LAS unsigned char* ab1 = lds + 128 * (wr * 64 + fr) + 16 * ((2 * fq + 1) ^ f8swz(fr));
    LAS unsigned char* bb0 = lds + 65536 + 128 * (wc * 32 + fr) + 16 * ((2 * fq) ^ f8swz(fr)); LAS unsigned char* bb1 = lds + 65536 + 128 * (wc * 32 + fr) + 16 * ((2 * fq + 1) ^ f8swz(fr));
    asm volatile("" : "+v"(ab0), "+v"(ab1), "+v"(bb0), "+v"(bb1));
#define PG8_SA(b, h) (((b) * 2 + (h)) * HTB)
#define PG8_SB(b, h) ((4 + (b) * 2 + (h)) * HTB)
#define PG8_STAGE(bufoff, gbase, voff) do { _Pragma("unroll") for (int _i = 0; _i < 2; ++_i) \
        __builtin_amdgcn_global_load_lds((const unsigned*)((const char*)(gbase) + _i * pstep + (voff)), (LAS unsigned*)(lds + (bufoff) + ldsw + _i * 8192), 16, 0, 0); } while (0)
#define PG8_LDA(dst, b, h) do { _Pragma("unroll") for (int m = 0; m < 4; ++m) { dst[m][0] = *(const LAS u32x4*)(ab0 + PG8_SA(b, h) + m * 2048); dst[m][1] = *(const LAS u32x4*)(ab1 + PG8_SA(b, h) + m * 2048); } } while (0)
#define PG8_LDB(dst, b, h) do { _Pragma("unroll") for (int n = 0; n < 2; ++n) { dst[n][0] = *(const LAS u32x4*)(bb0 + PG8_SA(b, h) + n * 2048); dst[n][1] = *(const LAS u32x4*)(bb1 + PG8_SA(b, h) + n * 2048); } } while (0)
#define PG8_CAT(x) __builtin_bit_cast(v8i32, __builtin_shufflevector((x)[0], (x)[1], 0, 1, 2, 3, 4, 5, 6, 7))
#define PG8_MMA(ai, bj, At, Bt) do { __builtin_amdgcn_s_setprio(1); _Pragma("unroll") for (int m = 0; m < 4; ++m) _Pragma("unroll") for (int n = 0; n < 2; ++n) \
        asm volatile("v_mfma_f32_16x16x128_f8f6f4 %0, %1, %2, %0" : "+v"(acc[ai][bj][m][n]) : "v"(PG8_CAT(Bt[n])), "v"(PG8_CAT(At[m]))); __builtin_amdgcn_s_setprio(0); } while (0)
#define PG8_WAIT_V(n) asm volatile("s_waitcnt vmcnt(" #n ")" ::: "memory")
#define PG8_WAIT_L(n) asm volatile("s_waitcnt lgkmcnt(" #n ")" ::: "memory")
#define PG8_BAR __builtin_amdgcn_s_barrier()
#define PG8_SCHED __builtin_amdgcn_sched_barrier(0)
    Unit cur, nxt; int ui = 0;
    if (!S.next(0, cur)) return;
    f32x4 acc[2][2][4][2];
#pragma unroll
    for (int a = 0; a < 2; ++a)
#pragma unroll
        for (int b = 0; b < 2; ++b)
#pragma unroll
            for (int m = 0; m < 4; ++m)
#pragma unroll
                for (int n = 0; n < 2; ++n) acc[a][b][m][n] = (f32x4){0.f, 0.f, 0.f, 0.f};
    u32x4 At[4][2], B0[2][2], B1[2][2];
    const char* cA = (const char*)g.A + (GATHER ? 0 : S.a_off(cur)); const char* cB = (const char*)g.Bt + S.b_off(cur);
    if constexpr (GATHER) { PG8_ROWOFF(offC, 0); }
    PG8_STAGE(PG8_SB(0, 0), cB, voffB); PG8_STAGE(PG8_SB(0, 1), cB + hstep, voffB); PG8_STAGE_A(0, 0, cA, 0, offC); PG8_STAGE_A(0, 1, cA, 0, offC);
    if (wr == 1) PG8_BAR;
    PG8_WAIT_V(2); PG8_BAR;
    PG8_STAGE(PG8_SB(1, 0), cB + kstep, voffB); PG8_STAGE_A(1, 0, cA + kstep, 128, offC); PG8_STAGE(PG8_SB(1, 1), cB + hstep + kstep, voffB);
    PG8_WAIT_V(6); PG8_BAR;
    for (;;) {
        const bool has_next = S.next(ui + 1, nxt);
        const char* nA = (has_next && !GATHER) ? (const char*)g.A + S.a_off(nxt) : cA; const char* nB = has_next ? (const char*)g.Bt + S.b_off(nxt) : cB;
        if constexpr (GATHER) { if (has_next) { PG8_ROWOFF(offN, ui + 1); } else {
#pragma unroll
            for (int _h = 0; _h < 2; ++_h)
#pragma unroll
                for (int _i = 0; _i < 2; ++_i) offN[_h][_i] = offC[_h][_i]; } }
#pragma nounroll
        for (int t = 0; t < nt; t += 2) {
            const bool last = (t == nt - 2);
            const char* a1 = cA + (size_t)(t + 1) * kstep;
            const char* a2 = last ? nA : cA + (size_t)(t + 2) * kstep; const char* b2 = last ? nB : cB + (size_t)(t + 2) * kstep;
            const char* a3 = a2 + kstep; const char* b3 = b2 + kstep;
            const int kb1 = (t + 1) * 128, kb2 = last ? 0 : (t + 2) * 128, kb3 = kb2 + 128;
            unsigned off2[2][2];
            if constexpr (GATHER) {
#pragma unroll
                for (int _h = 0; _h < 2; ++_h)
#pragma unroll
                    for (int _i = 0; _i < 2; ++_i) off2[_h][_i] = last ? offN[_h][_i] : offC[_h][_i]; }
            PG8_LDB(B0, 0, 0); PG8_LDB(B1, 0, 1); PG8_SCHED; PG8_LDA(At, 0, 0); PG8_STAGE_A(1, 1, a1, kb1, offC);
            PG8_WAIT_V(8); PG8_WAIT_L(0); PG8_BAR; PG8_MMA(0, 0, At, B0); PG8_MMA(0, 1, At, B1); PG8_BAR; PG8_SCHED;
            PG8_LDA(At, 0, 1); PG8_STAGE(PG8_SB(0, 0), b2, voffB); PG8_STAGE(PG8_SB(0, 1), b2 + hstep, voffB); PG8_STAGE_A(0, 0, a2, kb2, off2);
            PG8_WAIT_V(8); PG8_WAIT_L(0); PG8_BAR; PG8_MMA(1, 0, At, B0); PG8_MMA(1, 1, At, B1); PG8_BAR; PG8_SCHED;
            PG8_LDB(B0, 1, 0); PG8_LDB(B1, 1, 1); PG8_SCHED; PG8_LDA(At, 1, 0); PG8_STAGE_A(0, 1, a2, kb2, off2);
            PG8_WAIT_V(8); PG8_WAIT_L(0); PG8_BAR; PG8_MMA(0, 0, At, B0); PG8_MMA(0, 1, At, B1); PG8_BAR; PG8_SCHED;
            PG8_LDA(At, 1, 1); PG8_STAGE(PG8_SB(1, 0), b3, voffB); PG8_STAGE(PG8_SB(1, 1), b3 + hstep, voffB); PG8_STAGE_A(1, 0, a3, kb3, off2);
            PG8_WAIT_V(8); PG8_WAIT_L(0); PG8_BAR; PG8_MMA(1, 0, At, B0); PG8_MMA(1, 1, At, B1); PG8_BAR; PG8_SCHED;
        }
        if constexpr (ALIGN_EPI) { if (wr == 0) PG8_BAR; }
        asm volatile("s_nop 15\n\ts_nop 7" ::: "memory");
        E(acc, cur, wr, wc, fr, fq);
        if (!has_next) break;
#pragma unroll
        for (int a = 0; a < 2; ++a)
#pragma unroll
            for (int b = 0; b < 2; ++b)
#pragma unroll
                for (int m = 0; m < 4; ++m)
#pragma unroll
                    for (int n = 0; n < 2; ++n) acc[a][b][m][n] = (f32x4){0.f, 0.f, 0.f, 0.f};
        cur = nxt; cA = nA; cB = nB; ++ui;
        if constexpr (GATHER) {
#pragma unroll
            for (int _h = 0; _h < 2; ++_h)
#pragma unroll
                for (int _i = 0; _i < 2; ++_i) offC[_h][_i] = offN[_h][_i]; }
        if constexpr (ALIGN_EPI) { if (wr == 1) PG8_BAR; }
    }
    PG8_WAIT_V(0);
    if constexpr (!ALIGN_EPI) { if (wr == 0) PG8_BAR; }
    PG8_BAR;
#undef PG8_ROWOFF
#undef PG8_STAGE_G
#undef PG8_STAGE_A
#undef PG8_SA
#undef PG8_SB
#undef PG8_STAGE
#undef PG8_LDA
#undef PG8_LDB
#undef PG8_CAT
#undef PG8_MMA
#undef PG8_WAIT_V
#undef PG8_WAIT_L
#undef PG8_BAR
#undef PG8_SCHED
}
}

constexpr size_t MiB = 1u << 20;
constexpr size_t WS_CTL = 0, CTL_ZERO_BYTES = 32768;
constexpr size_t WS_WIN = 1 * MiB, WS_WO = 5 * MiB;
constexpr size_t WS_TAB = 7 * MiB;
constexpr size_t WS_TOPI = 8 * MiB, WS_GATE = WS_TOPI + 256 * 1024, WS_LRANK = WS_GATE + 256 * 1024, WS_POS = WS_LRANK + 256 * 1024;
constexpr size_t WS_RSTD = 12 * MiB, WS_INV = 13 * MiB;
constexpr int CW_CNT = 256;
constexpr size_t WS_ML = 9 * MiB;
constexpr size_t WS_WGU = 16 * MiB, WS_WD = 144 * MiB, WS_XN = 208 * MiB;
constexpr size_t WS_U = 240 * MiB, WS_Q = 256 * MiB, WS_K = 272 * MiB, WS_V = 288 * MiB;
constexpr size_t WS_OB = 304 * MiB, WS_MIX = 352 * MiB, WS_XMID = 384 * MiB, WS_XS = 448 * MiB, WS_ACT = 592 * MiB, WS_Y = 736 * MiB, WS_END = 880 * MiB;
constexpr int CW_BAR = 4096;

constexpr int RING_BYTES = 131072, LDSCTL_OFF = RING_BYTES, MISC_OFF = LDSCTL_OFF + 320;
constexpr int LDS_NMT_OFF = LDSCTL_OFF + 512, LDS_TAB_OFF = LDSCTL_OFF + 1024, LDS_TOPI_OFF = LDSCTL_OFF + 4096, LDS_P6_OFF = LDSCTL_OFF + 8192, LDS_G_OFF = LDSCTL_OFF + 8192, LDS_ROWT_OFF = LDSCTL_OFF + 12288;
constexpr int MAX_UNITS = 10;
constexpr int LDS_RSTB_OFF = LDS_ROWT_OFF + MAX_UNITS * 1024;
constexpr int LDS_BYTES = 163840;

#define XB_TMO      128
#define XB_XCNT(j)  (256  + 64 * (j))
#define XB_XSUB(j)  (1280 + 64 * (j))
#define XB_XGEN(j)  (2304 + 64 * (j))
#define XB_TOP      3328
#define XB_TOPGEN   3392
#define XCD_BAR_WORDS 3456
#define XB_SPIN_CAP (1u << 18)
__device__ __forceinline__ unsigned xb_ld(unsigned* p)              { return __hip_atomic_load(p, __ATOMIC_RELAXED, __HIP_MEMORY_SCOPE_AGENT); }
__device__ __forceinline__ unsigned xb_add(unsigned* p, unsigned v) { return __hip_atomic_fetch_add(p, v, __ATOMIC_RELAXED, __HIP_MEMORY_SCOPE_AGENT); }
__device__ __forceinline__ unsigned xb_xcc_id() { return (unsigned)__builtin_amdgcn_s_getreg((3 << 11) | 20) & 0xFu; }
#define XB_SPIN(cond, bar) do { unsigned _sp = 0; while (cond) { __builtin_amdgcn_s_sleep(1); \
    if ((++_sp & 255u) == 0u) { if (xb_ld(&(bar)[XB_TMO])) break; if (_sp > XB_SPIN_CAP) { atomicAdd(&(bar)[XB_TMO], 1u); break; } } } } while (0)
struct XcdBarrier { unsigned* bar; unsigned x; volatile LAS unsigned* st; };
__device__ __forceinline__ XcdBarrier xcd_barrier_post(unsigned* bar, volatile LAS unsigned* st) {
    XcdBarrier b; b.bar = bar; b.x = xb_xcc_id(); b.st = st;
    if (threadIdx.x == 0) (void)xb_add(&bar[XB_XCNT(b.x)], 1u);
    return b;
}
__device__ __forceinline__ void xcd_barrier_complete(unsigned* bar, unsigned x, unsigned& nloc, unsigned& nx) {
    const unsigned G = gridDim.x * gridDim.y * gridDim.z;
    unsigned sum, cnt, mine, sp = 0u;
    for (;;) {
        sum = 0u; cnt = 0u; mine = 0u;
#pragma unroll
        for (unsigned j = 0; j < 16; ++j) { const unsigned c = xb_ld(&bar[XB_XCNT(j)]); sum += c; cnt += (c > 0u) ? 1u : 0u; mine = (j == x) ? c : mine; }
        if (sum == G) break;
        __builtin_amdgcn_s_sleep(1);
        if ((++sp & 255u) == 0u) { if (xb_ld(&bar[XB_TMO])) break; if (sp > XB_SPIN_CAP) { atomicAdd(&bar[XB_TMO], 1u); break; } }
    }
    nloc = mine > 0u ? mine : 1u; nx = cnt > 0u ? cnt : 1u;
}
__device__ __forceinline__ void xcd_barrier(const XcdBarrier& b) {
    asm volatile("s_waitcnt vmcnt(0)" ::: "memory");
    __syncthreads();
    if (threadIdx.x == 0) {
        unsigned* bar = b.bar;
        __builtin_amdgcn_s_waitcnt(0);
        unsigned nloc = b.st[0], nx = b.st[1];
        if (nloc == 0u) { xcd_barrier_complete(bar, b.x, nloc, nx); b.st[0] = nloc; b.st[1] = nx; }
        const unsigned old = xb_add(&bar[XB_XSUB(b.x)], 1u);
        const unsigned gen = old / nloc;
        if (old + 1u == (gen + 1u) * nloc) {
            __builtin_amdgcn_fence(__ATOMIC_RELEASE, "agent");
            asm volatile("s_waitcnt vmcnt(0)" ::: "memory");
            const unsigned og = xb_add(&bar[XB_TOP], 1u);
            const unsigned tg = og / nx;
            if (og + 1u == (tg + 1u) * nx) xb_add(&bar[XB_TOPGEN], 1u);
            else XB_SPIN(xb_ld(&bar[XB_TOPGEN]) == tg, bar);
            __builtin_amdgcn_fence(__ATOMIC_ACQUIRE, "agent");
            xb_add(&bar[XB_XGEN(b.x)], 1u);
            asm volatile("s_waitcnt vmcnt(0)" ::: "memory");
        } else {
            XB_SPIN(xb_ld(&bar[XB_XGEN(b.x)]) == gen, bar);
            __builtin_amdgcn_fence(__ATOMIC_ACQUIRE, "agent");
            asm volatile("s_waitcnt vmcnt(0)" ::: "memory");
        }
    }
    __syncthreads();
}

__device__ __forceinline__ float wave_sum(float v) {
#pragma unroll
    for (int o = 1; o < 64; o <<= 1) v += __shfl_xor(v, o);
    return v;
}
__device__ __forceinline__ void rms_row_to_bf16(const float* xrow, const float* g, bf16_t* orow, int lane) {
    const f32x4* xr = (const f32x4*)xrow + lane; const f32x4* gr = (const f32x4*)g + lane;
    f32x4 v[4]; float s = 0.f;
#pragma unroll
    for (int j = 0; j < 4; ++j) { v[j] = __builtin_nontemporal_load(xr + 64 * j); s += (v[j].x * v[j].x + v[j].y * v[j].y) + (v[j].z * v[j].z + v[j].w * v[j].w); }
    const float rstd = 1.0f / sqrtf(wave_sum(s) * (1.f / D) + EPS);
    u32x2* o8 = (u32x2*)orow + lane;
#pragma unroll
    for (int j = 0; j < 4; ++j) { const f32x4 gv = gr[64 * j]; u32x2 w; w.x = pkbf(v[j].x * rstd * gv.x, v[j].y * rstd * gv.y); w.y = pkbf(v[j].z * rstd * gv.z, v[j].w * rstd * gv.w); o8[64 * j] = w; }
}
__device__ __forceinline__ void transpose64(const float* W, int ldn, bf16_t* WT, int ldk, int k0, int n0, int drow0, int dcol0, LAS unsigned char* scr, int lane) {
    const int nc = lane & 15, kq = lane >> 4;
    const float* src = W + (size_t)(k0 + 16 * kq) * ldn + n0 + 4 * nc;
    f32x4 v[16];
#pragma unroll
    for (int it = 0; it < 16; ++it) v[it] = *(const f32x4*)(src + (size_t)it * ldn);
    const int x = nc & 7;
#pragma unroll
    for (int c = 0; c < 4; ++c) { const int n = 4 * nc + c;
        u32x4 lo, hi;
        lo.x = pkbf(v[0][c], v[1][c]); lo.y = pkbf(v[2][c], v[3][c]); lo.z = pkbf(v[4][c], v[5][c]); lo.w = pkbf(v[6][c], v[7][c]);
        hi.x = pkbf(v[8][c], v[9][c]); hi.y = pkbf(v[10][c], v[11][c]); hi.z = pkbf(v[12][c], v[13][c]); hi.w = pkbf(v[14][c], v[15][c]);
        *(LAS u32x4*)(scr + 128 * n + 16 * ((2 * kq) ^ x)) = lo;
        *(LAS u32x4*)(scr + 128 * n + 16 * ((2 * kq + 1) ^ x)) = hi; }
#pragma unroll
    for (int j = 0; j < 8; ++j) { const int n = (lane >> 3) + 8 * j, c = lane & 7, xx = (n >> 2) & 7;
        const u32x4 o = *(const LAS u32x4*)(scr + 128 * n + 16 * (c ^ xx));
        *(u32x4*)(WT + (size_t)(drow0 + n) * ldk + dcol0 + 8 * c) = o; }
}
__device__ __forceinline__ void weff_item(const float* w_pool, const float* pool_scale, const float* w_out, bf16_t* WoT, int item, LAS float* scr, int lane) {
    const int nb = item & 15, cb = (item >> 4) & 15, g = item >> 8;
#pragma unroll
    for (int q = 0; q < 16; ++q) { const int idx = lane + 64 * q, i = idx >> 7, dp = idx & 127; scr[idx] = w_pool[(size_t)(g * 128 + 8 * cb + i) * 128 + dp] * pool_scale[g * 128 + dp]; }
    float acc[8];
#pragma unroll
    for (int i = 0; i < 8; ++i) acc[i] = 0.f;
    const float* wo = w_out + (size_t)(g * 128) * 1024 + nb * 64 + lane;
    for (int dp = 0; dp < 128; dp += 4) {
        const float w0 = wo[(size_t)(dp + 0) * 1024], w1 = wo[(size_t)(dp + 1) * 1024], w2 = wo[(size_t)(dp + 2) * 1024], w3 = wo[(size_t)(dp + 3) * 1024];
#pragma unroll
        for (int i = 0; i < 8; ++i) { const f32x4 s = *(const LAS f32x4*)(scr + i * 128 + dp); acc[i] += (s.x * w0 + s.y * w1) + (s.z * w2 + s.w * w3); }
    }
    u32x4 o; o.x = pkbf(acc[0], acc[1]); o.y = pkbf(acc[2], acc[3]); o.z = pkbf(acc[4], acc[5]); o.w = pkbf(acc[6], acc[7]);
    *(u32x4*)(WoT + (size_t)(nb * 64 + lane) * 1024 + g * 128 + 8 * cb) = o;
}

constexpr int I_GU = 32 * 8 * 32, I_DN = 32 * 8 * 16, N_WITEMS = I_GU + I_DN;
struct WItem { const float* src; unsigned char* dst; int ldn; };
__device__ __forceinline__ WItem witem_decode(int r, const float* w_gu, const float* w_down, unsigned char* WguT, unsigned char* WdT) {
    WItem w;
    if (r < I_GU) { const int e = r >> 8, kb = (r >> 5) & 7, nb = r & 31, n0 = 64 * nb;
        const int drow = (n0 < 1024) ? ((n0 >> 7) * 256 + (n0 & 127)) : (((n0 - 1024) >> 7) * 256 + 128 + ((n0 - 1024) & 127));
        w.src = w_gu + (size_t)e * 1024 * 2048 + (size_t)(128 * kb) * 2048 + n0; w.dst = WguT + (size_t)e * 2048 * 1024 + (size_t)drow * 1024 + 128 * kb; w.ldn = 2048; }
    else { r -= I_GU; const int e = r >> 7, kb = (r >> 4) & 7, nb = r & 15;
        w.src = w_down + (size_t)e * 1024 * 1024 + (size_t)(128 * kb) * 1024 + 64 * nb; w.dst = WdT + (size_t)e * 1024 * 1024 + (size_t)(64 * nb) * 1024 + 128 * kb; w.ldn = 1024; }
    return w;
}
__device__ __forceinline__ void witem_issue(const WItem& w, int half, f32x4 (&v)[16], int lane) {
    const int nc = lane & 15, kq = lane >> 4;
    const float* src = w.src + (size_t)(32 * kq + 16 * half) * w.ldn + 4 * nc;
#pragma unroll
    for (int it = 0; it < 16; ++it) v[it] = __builtin_nontemporal_load((const f32x4*)(src + (size_t)it * w.ldn));
}
__device__ __forceinline__ void witem_finish(const WItem& w, int half, const f32x4 (&v)[16], LAS unsigned char* scr, int lane) {
    const int nc = lane & 15, kq = lane >> 4, x = nc & 7;
#pragma unroll
    for (int c = 0; c < 4; ++c) { const int n = 4 * nc + c;
        u32x4 q; q.x = pk4f8(v[0][c] * W_SCALE, v[1][c] * W_SCALE, v[2][c] * W_SCALE, v[3][c] * W_SCALE); q.y = pk4f8(v[4][c] * W_SCALE, v[5][c] * W_SCALE, v[6][c] * W_SCALE, v[7][c] * W_SCALE);
        q.z = pk4f8(v[8][c] * W_SCALE, v[9][c] * W_SCALE, v[10][c] * W_SCALE, v[11][c] * W_SCALE); q.w = pk4f8(v[12][c] * W_SCALE, v[13][c] * W_SCALE, v[14][c] * W_SCALE, v[15][c] * W_SCALE);
        *(LAS u32x4*)(scr + 128 * n + 16 * ((2 * kq + half) ^ x)) = q; }
    if (half == 1) {
#pragma unroll
        for (int j = 0; j < 8; ++j) { const int n = (lane >> 3) + 8 * j, c = lane & 7, xx = (n >> 2) & 7;
            const u32x4 o = *(const LAS u32x4*)(scr + 128 * n + 16 * (c ^ xx));
            __builtin_nontemporal_store(o, (u32x4*)(w.dst + (size_t)n * 1024 + 16 * c)); }
    }
}

struct AttU { int b, h, br, dil, r, n; };
__device__ __forceinline__ AttU att_decode(int u) {
    u = u % 3072; AttU a; const int bh = u / 48, sub = u % 48; a.b = bh >> 3; a.h = bh & 7; a.br = sub >> 4; const int j = sub & 15;
    if (a.br == 0) { a.dil = 1; a.r = 0; a.n = j; } else if (a.br == 1) { a.dil = 4; a.r = j >> 2; a.n = j & 3; } else { a.dil = 16; a.r = j; a.n = 0; }
    return a;
}
__device__ __forceinline__ void attn_phase(LAS unsigned char* lds, const bf16_t* Qb, const bf16_t* Kb, const bf16_t* Vb, bf16_t* OB, float* ML, int vcu, int G, int tid,
                                           const float* w_gu, const float* w_down, unsigned char* WguT, unsigned char* WdT) {
    constexpr int NU = 64 * 48 * DUPN(2);
    const int lane = tid & 63, wid = rfl(tid >> 6), i16 = lane & 15, fq = lane >> 4;
    const int gwv = vcu * 8 + wid, NGWv = G * 8;
    LAS unsigned char* wscr = lds + 65536 + wid * 8192;
    f32x4 wv[16]; WItem wi; wi.src = nullptr; wi.dst = nullptr; wi.ldn = 0;
    int step = 0;
    u32x4 kreg[4], vreg[4], qreg[2];
    int u = vcu;
    if (u < NU) { const AttU a = att_decode(u);
#pragma unroll
        for (int p = 0; p < 4; ++p) { const int q = tid + 512 * p, row = q >> 3, c = q & 7; int cp = (a.n - 1) * 128 + row; cp = cp < 0 ? 0 : cp;
            const size_t off = (size_t)(a.b * SEQ + cp * a.dil + a.r) * 512 + a.h * 64 + c * 8; kreg[p] = *(const u32x4*)(Kb + off); vreg[p] = *(const u32x4*)(Vb + off); }
        const bf16_t* qp = Qb + (size_t)(a.b * SEQ + (a.n * 128 + 16 * wid + i16) * a.dil + a.r) * 512 + a.h * 64 + 8 * fq;
        qreg[0] = *(const u32x4*)(qp); qreg[1] = *(const u32x4*)(qp + 32); }
    bool wact = (u < NU) && (gwv < N_WITEMS);
    if (wact) { wi = witem_decode(gwv, w_gu, w_down, WguT, WdT); witem_issue(wi, 0, wv, lane); }
    for (; u < NU; u += G, ++step) {
        const AttU a = att_decode(u);
#pragma unroll
        for (int p = 0; p < 4; ++p) { const int q = tid + 512 * p, row = q >> 3, c = q & 7;
            *(LAS u32x4*)(lds + 128 * row + 16 * (c ^ ((row >> 1) & 7))) = kreg[p];
            *(LAS u32x4*)(lds + 32768 + 128 * row + 32 * ((c >> 1) ^ ((row >> 1) & 3)) + 16 * (c & 1)) = vreg[p]; }
        const bf16x8 qf0 = __builtin_bit_cast(bf16x8, qreg[0]), qf1 = __builtin_bit_cast(bf16x8, qreg[1]);
        __syncthreads();
        const int un = u + G;
        if (un < NU) { const AttU a2 = att_decode(un);
#pragma unroll
            for (int p = 0; p < 4; ++p) { const int q = tid + 512 * p, row = q >> 3, c = q & 7; int cp = (a2.n - 1) * 128 + row; cp = cp < 0 ? 0 : cp;
                const size_t off = (size_t)(a2.b * SEQ + cp * a2.dil + a2.r) * 512 + a2.h * 64 + c * 8; kreg[p] = *(const u32x4*)(Kb + off); vreg[p] = *(const u32x4*)(Vb + off); }
            const bf16_t* qp = Qb + (size_t)(a2.b * SEQ + (a2.n * 128 + 16 * wid + i16) * a2.dil + a2.r) * 512 + a2.h * 64 + 8 * fq;
            qreg[0] = *(const u32x4*)(qp); qreg[1] = *(const u32x4*)(qp + 32); }
        asm volatile("" ::: "memory");
        const int qi = 16 * wid + i16;
        const size_t tokq = (size_t)(a.b * SEQ + (a.n * 128 + qi) * a.dil + a.r);
        f32x4 sc[9];
#pragma unroll
        for (int kt = 0; kt < 9; ++kt) { const int row = 16 * (wid + kt) + i16, xr = (row >> 1) & 7;
            const bf16x8 a0 = *(const LAS bf16x8*)(lds + 128 * row + 16 * (fq ^ xr)), a1 = *(const LAS bf16x8*)(lds + 128 * row + 16 * ((4 + fq) ^ xr));
            f32x4 z = (f32x4){0.f, 0.f, 0.f, 0.f};
            z = __builtin_amdgcn_mfma_f32_16x16x32_bf16(a0, qf0, z, 0, 0, 0);
            sc[kt] = __builtin_amdgcn_mfma_f32_16x16x32_bf16(a1, qf1, z, 0, 0, 0); }
        float mx = -1e30f;
#pragma unroll
        for (int kt = 0; kt < 9; ++kt)
#pragma unroll
            for (int j = 0; j < 4; ++j) { bool valid = true; if (kt == 0) valid = (i16 <= 4 * fq + j); if (kt == 8) valid = (4 * fq + j <= i16);
                if (a.n == 0 && wid + kt < 8) valid = false;
                const float s = valid ? sc[kt][j] : -1e30f; sc[kt][j] = s; mx = fmaxf(mx, s); }
        mx = fmaxf(mx, __shfl_xor(mx, 16)); mx = fmaxf(mx, __shfl_xor(mx, 32));
        float l = 0.f;
#pragma unroll
        for (int kt = 0; kt < 9; ++kt)
#pragma unroll
            for (int j = 0; j < 4; ++j) { const float p = __builtin_amdgcn_exp2f(sc[kt][j] - mx); sc[kt][j] = p; l += p; }
        l += __shfl_xor(l, 16); l += __shfl_xor(l, 32);
        f32x4 o[4];
#pragma unroll
        for (int dt = 0; dt < 4; ++dt) o[dt] = (f32x4){0.f, 0.f, 0.f, 0.f};
        const int qq = i16 >> 2, pp = i16 & 3;
#pragma unroll
        for (int sl = 0; sl < 5; ++sl) {
            const int row0 = 16 * (wid + 2 * sl) + 4 * fq + qq, row1 = (sl == 4) ? row0 : row0 + 16;
            u32x4 pw; pw.x = pkbf(sc[2 * sl][0], sc[2 * sl][1]); pw.y = pkbf(sc[2 * sl][2], sc[2 * sl][3]);
            if (sl < 4) { pw.z = pkbf(sc[(2 * sl + 1) % 9][0], sc[(2 * sl + 1) % 9][1]); pw.w = pkbf(sc[(2 * sl + 1) % 9][2], sc[(2 * sl + 1) % 9][3]); } else { pw.z = 0u; pw.w = 0u; }
            const bf16x8 pf = __builtin_bit_cast(bf16x8, pw);
#pragma unroll
            for (int dt = 0; dt < 4; ++dt) {
                const v4i16_t t0 = __builtin_amdgcn_ds_read_tr16_b64_v4i16((LAS v4i16_t*)(lds + 32768 + 128 * row0 + 32 * (dt ^ ((row0 >> 1) & 3)) + 8 * pp));
                const v4i16_t t1 = __builtin_amdgcn_ds_read_tr16_b64_v4i16((LAS v4i16_t*)(lds + 32768 + 128 * row1 + 32 * (dt ^ ((row1 >> 1) & 3)) + 8 * pp));
                const bf16x8 af = (bf16x8){t0[0], t0[1], t0[2], t0[3], t1[0], t1[1], t1[2], t1[3]};
                o[dt] = __builtin_amdgcn_mfma_f32_16x16x32_bf16(af, pf, o[dt], 0, 0, 0);
            }
        }
        const float inv = 1.0f / l;
        bf16_t* op = OB + ((size_t)a.br * T + tokq) * 512 + a.h * 64 + 4 * fq;
#pragma unroll
        for (int dt = 0; dt < 4; ++dt) { u32x2 w; w.x = pkbf(o[dt][0] * inv, o[dt][1] * inv); w.y = pkbf(o[dt][2] * inv, o[dt][3] * inv); *(u32x2*)(op + 16 * dt) = w; }
        if (fq == 0) { f32x2 ml; ml.x = mx; ml.y = l; *(f32x2*)(ML + (((size_t)a.br * T + tokq) * 8 + a.h) * 2) = ml; }
        if (wact) witem_finish(wi, step & 1, wv, wscr, lane);
        {
            const int ns = step + 1, nitem = gwv + (ns >> 1) * NGWv; const bool nact = (u + G < NU) && (nitem < N_WITEMS);
            if (nact) { if ((ns & 1) == 0) wi = witem_decode(nitem, w_gu, w_down, WguT, WdT); witem_issue(wi, ns & 1, wv, lane); }
            wact = nact;
        }
        __syncthreads();
    }
    if (step & 1) { const int witem = gwv + (step >> 1) * NGWv; if (witem < N_WITEMS) { witem_issue(wi, 1, wv, lane); witem_finish(wi, 1, wv, wscr, lane); } ++step; }
    for (int witem = gwv + (step >> 1) * NGWv; witem < N_WITEMS; witem += NGWv) { wi = witem_decode(witem, w_gu, w_down, WguT, WdT);
        witem_issue(wi, 0, wv, lane); witem_finish(wi, 0, wv, wscr, lane); witem_issue(wi, 1, wv, lane); witem_finish(wi, 1, wv, wscr, lane); }
}

struct Args { const float* in[14]; float* out; unsigned char* ws; };
constexpr int NWAVES = 8;

__global__ void __launch_bounds__(NWAVES * 64, 2) mega_fwd(Args args) {
    extern __shared__ __attribute__((aligned(16))) unsigned char lds_raw[];
    LAS unsigned char* lds = (LAS unsigned char*)lds_raw;
    volatile LAS unsigned* MISC = (volatile LAS unsigned*)(lds + MISC_OFF);
    const int tid = threadIdx.x, lane = tid & 63, wave = rfl(tid >> 6);
    const int G = gridDim.x; const int bx = blockIdx.x; const int vcu = (G % 8 == 0) ? (bx % 8) * (G / 8) + bx / 8 : bx;
    unsigned char* ws = args.ws;
    const float* x = args.in[0]; const float* g_mix = args.in[1]; const float* w_in = args.in[2]; const float* w_pool = args.in[3]; const float* pool_scale = args.in[4];
    const float* w_out = args.in[5]; const float* g_ffn = args.in[6]; const float* w_router = args.in[7]; const float* b_router = args.in[8];
    const float* w_gu = args.in[9]; const float* b_gu = args.in[10]; const float* w_down = args.in[11]; const float* b_down = args.in[12]; const float* g_final = args.in[13];
    float* out = args.out;
    bf16_t* WinT = (bf16_t*)(ws + WS_WIN); bf16_t* WoT = (bf16_t*)(ws + WS_WO); unsigned char* WguT = ws + WS_WGU; unsigned char* WdT = ws + WS_WD;
    bf16_t* XN = (bf16_t*)(ws + WS_XN); bf16_t* Ub = (bf16_t*)(ws + WS_U); bf16_t* Qb = (bf16_t*)(ws + WS_Q); bf16_t* Kb = (bf16_t*)(ws + WS_K); bf16_t* Vb = (bf16_t*)(ws + WS_V);
    bf16_t* OB = (bf16_t*)(ws + WS_OB); float* ML = (float*)(ws + WS_ML); bf16_t* MIX = (bf16_t*)(ws + WS_MIX); float* XMID = (float*)(ws + WS_XMID);
    unsigned char* XS = ws + WS_XS; unsigned char* ACT = ws + WS_ACT; unsigned char* Yb = ws + WS_Y;
    int* TOPI = (int*)(ws + WS_TOPI); float* GATE = (float*)(ws + WS_GATE); int* LRANK = (int*)(ws + WS_LRANK);
    unsigned* CNT = (unsigned*)(ws + WS_CTL) + CW_CNT; int* INV = (int*)(ws + WS_INV);

    for (int u = tid; u < (LDS_BYTES - LDSCTL_OFF) / 4; u += NWAVES * 64) ((LAS unsigned*)(lds + LDSCTL_OFF))[u] = 0u;
    __syncthreads();
    XcdBarrier bar = xcd_barrier_post((unsigned*)(ws + WS_CTL) + CW_BAR, MISC + 8);
    const int gw = vcu * NWAVES + wave, NGW = G * NWAVES;

    {
        LAS unsigned char* scr = lds + wave * 16384;
        constexpr int I_IN = 16 * 32, I_OUT = 8 * 16, NITEMS = I_IN + I_OUT;
        for (int it = gw; it < NITEMS; it += NGW) {
            int r = it;
            if (r < I_IN) { const int kb = r >> 5, nb = r & 31; transpose64(w_in, 2048, WinT, 1024, 64 * kb, 64 * nb, 64 * nb, 64 * kb, scr, lane); continue; } r -= I_IN;
            { const int kb = r >> 4, nb = r & 15; transpose64(w_out + (size_t)512 * 1024, 1024, WoT, 1024, 64 * kb, 64 * nb, 64 * nb, 512 + 64 * kb, scr, lane); }
        }
        for (int q = gw * 64 + lane; q < 4096; q += NGW * 64) { const int e = q & 31, k8 = q >> 5;
            float wv[8], rv[8];
#pragma unroll
            for (int j = 0; j < 8; ++j) wv[j] = w_router[(size_t)(8 * k8 + j) * 32 + e];
            u32x4 H; H.x = pkbf(wv[0], wv[1]); H.y = pkbf(wv[2], wv[3]); H.z = pkbf(wv[4], wv[5]); H.w = pkbf(wv[6], wv[7]);
            rv[0] = wv[0] - bflo(H.x); rv[1] = wv[1] - bfhi(H.x); rv[2] = wv[2] - bflo(H.y); rv[3] = wv[3] - bfhi(H.y); rv[4] = wv[4] - bflo(H.z); rv[5] = wv[5] - bfhi(H.z); rv[6] = wv[6] - bflo(H.w); rv[7] = wv[7] - bfhi(H.w);
            u32x4 L; L.x = pkbf(rv[0], rv[1]); L.y = pkbf(rv[2], rv[3]); L.z = pkbf(rv[4], rv[5]); L.w = pkbf(rv[6], rv[7]);
            *(u32x4*)(ws + WS_TAB + 2048 * e + 16 * (k8 ^ (e & 15))) = H; *(u32x4*)(ws + WS_TAB + 65536 + 2048 * e + 16 * (k8 ^ (e & 15))) = L; }
        for (int it = gw; it < DUPN(10) * 1024; it += NGW) weff_item(w_pool, pool_scale, w_out, WoT, it & 1023, (LAS float*)scr, lane);
        for (int m = gw; m < DUPN(11) * T; m += NGW) rms_row_to_bf16(x + (size_t)(m & (T - 1)) * D, g_mix, XN + (size_t)(m & (T - 1)) * D, lane);
    }
    xcd_barrier(bar);

    {
        pg8::Gemm g{XN, WinT, D}; pg8::StaticOrder S; S.init(T, 2048, D * 2, G, bx);
        pg8::EpiQKV E{Ub, (size_t)T * 512, QSCALE};
        pg8::gemm_phase<pg8::EpiQKV, pg8::StaticOrder, true>(lds, g, S, E);
    }
    xcd_barrier(bar);
#if (PROBE_DUP >> 1) & 1
    {
        pg8::Gemm g{XN, WinT, D}; pg8::StaticOrder S; S.init(T, 2048, D * 2, G, bx);
        pg8::EpiQKV E{Ub, (size_t)T * 512, QSCALE};
        pg8::gemm_phase<pg8::EpiQKV, pg8::StaticOrder, true>(lds, g, S, E);
    }
    xcd_barrier(bar);
#endif

    attn_phase(lds, Qb, Kb, Vb, OB, ML, vcu, G, tid, w_gu, w_down, WguT, WdT);
    xcd_barrier(bar);

    for (int run_ = gw; run_ < DUPN(3) * (T / 8); run_ += NGW) {
        const int run = run_ & (T / 8 - 1);
        const int t0 = run * 8, ts0 = t0 & (SEQ - 1), grp = lane >> 4, w = 2 << grp;
        u32x4 cur[8], old[8];
#pragma unroll
        for (int i = 0; i < 8; ++i) { cur[i] = *(const u32x4*)(Ub + (size_t)(t0 + i) * 512 + 8 * lane);
            const int to = (ts0 + i >= w - 1) ? (t0 + i - w + 1) : (t0 + i);
            old[i] = *(const u32x4*)(Ub + (size_t)to * 512 + 8 * lane); }
        float S[8];
#pragma unroll
        for (int i = 0; i < 8; ++i) S[i] = 0.f;
#pragma unroll
        for (int j = 1; j < 16; ++j) {
            if (j < w && j <= ts0) { const u32x4 v = *(const u32x4*)(Ub + (size_t)(t0 - j) * 512 + 8 * lane);
                S[0] += bflo(v.x); S[1] += bfhi(v.x); S[2] += bflo(v.y); S[3] += bfhi(v.y); S[4] += bflo(v.z); S[5] += bfhi(v.z); S[6] += bflo(v.w); S[7] += bfhi(v.w); }
        }
#pragma unroll
        for (int i = 0; i < 8; ++i) {
            const int t = t0 + i, ts = ts0 + i;
            const float c0 = bflo(cur[i].x), c1 = bfhi(cur[i].x), c2 = bflo(cur[i].y), c3 = bfhi(cur[i].y), c4 = bflo(cur[i].z), c5 = bfhi(cur[i].z), c6 = bflo(cur[i].w), c7 = bfhi(cur[i].w);
            S[0] += c0; S[1] += c1; S[2] += c2; S[3] += c3; S[4] += c4; S[5] += c5; S[6] += c6; S[7] += c7;
            const int cnt = (ts + 1 < w) ? ts + 1 : w; const float ic = 1.0f / (float)cnt;
            u32x4 pw; pw.x = pkbf(S[0] * ic - c0, S[1] * ic - c1); pw.y = pkbf(S[2] * ic - c2, S[3] * ic - c3); pw.z = pkbf(S[4] * ic - c4, S[5] * ic - c5); pw.w = pkbf(S[6] * ic - c6, S[7] * ic - c7);
            *(u32x4*)(MIX + (size_t)t * 1024 + 8 * lane) = pw;
            if (ts >= w - 1) { const u32x4 v = old[i];
                S[0] -= bflo(v.x); S[1] -= bfhi(v.x); S[2] -= bflo(v.y); S[3] -= bfhi(v.y); S[4] -= bflo(v.z); S[5] -= bfhi(v.z); S[6] -= bflo(v.w); S[7] -= bfhi(v.w); }
        }
        const int h = lane >> 3;
#pragma unroll
        for (int bt = 0; bt < 2; ++bt) {
            f32x2 mlv[4][3]; u32x4 ov[4][3];
#pragma unroll
            for (int i = 0; i < 4; ++i)
#pragma unroll
                for (int br = 0; br < 3; ++br) { const int t = t0 + 4 * bt + i;
                    mlv[i][br] = __builtin_nontemporal_load((const f32x2*)(ML + (((size_t)br * T + t) * 8 + h) * 2)); ov[i][br] = __builtin_nontemporal_load((const u32x4*)(OB + ((size_t)br * T + t) * 512 + 8 * lane)); }
#pragma unroll
            for (int i = 0; i < 4; ++i) { const int t = t0 + 4 * bt + i;
                const float mall = fmaxf(mlv[i][0].x, fmaxf(mlv[i][1].x, mlv[i][2].x));
                float w0 = mlv[i][0].y * __builtin_amdgcn_exp2f(mlv[i][0].x - mall), w1 = mlv[i][1].y * __builtin_amdgcn_exp2f(mlv[i][1].x - mall), w2 = mlv[i][2].y * __builtin_amdgcn_exp2f(mlv[i][2].x - mall);
                const float it = 1.0f / (w0 + w1 + w2); w0 *= it; w1 *= it; w2 *= it;
                const u32x4 o0 = ov[i][0], o1 = ov[i][1], o2 = ov[i][2];
                u32x4 aw;
                aw.x = pkbf(w0 * bflo(o0.x) + w1 * bflo(o1.x) + w2 * bflo(o2.x), w0 * bfhi(o0.x) + w1 * bfhi(o1.x) + w2 * bfhi(o2.x));
                aw.y = pkbf(w0 * bflo(o0.y) + w1 * bflo(o1.y) + w2 * bflo(o2.y), w0 * bfhi(o0.y) + w1 * bfhi(o1.y) + w2 * bfhi(o2.y));
                aw.z = pkbf(w0 * bflo(o0.z) + w1 * bflo(o1.z) + w2 * bflo(o2.z), w0 * bfhi(o0.z) + w1 * bfhi(o1.z) + w2 * bfhi(o2.z));
                aw.w = pkbf(w0 * bflo(o0.w) + w1 * bflo(o1.w) + w2 * bflo(o2.w), w0 * bfhi(o0.w) + w1 * bfhi(o1.w) + w2 * bfhi(o2.w));
                *(u32x4*)(MIX + (size_t)t * 1024 + 512 + 8 * lane) = aw; }
        }
    }
    xcd_barrier(bar);

#if (PROBE_DUP >> 14) & 1
    {
        unsigned* CHK = (unsigned*)(ws + WS_CTL) + 2;
        for (int s_ = gw; s_ < 700 * 8; s_ += NGW) {
            const int si = s_ >> 3, h = s_ & 7;
            const int t = (si < 256) ? ((si >> 5) * SEQ + (si & 31) * ((si & 1) ? 1 : 9)) % T : (int)(((long)si * 7919) % T);
            const int ts = t & (SEQ - 1), b = t >> 11;
            float sc[3][3]; float mx = -1e30f;
#pragma unroll
            for (int br = 0; br < 3; ++br) { const int dil = (br == 0) ? 1 : (br == 1 ? 4 : 16);
#pragma unroll
                for (int c = 0; c < 3; ++c) { const int j = lane + 64 * c; float s = -1e30f;
                    if (j <= 128 && j <= ts / dil) { const int tk = b * SEQ + ts - j * dil; float acc = 0.f;
                        for (int d = 0; d < 64; ++d) acc += __uint_as_float((unsigned)Qb[(size_t)t * 512 + h * 64 + d] << 16) * __uint_as_float((unsigned)Kb[(size_t)tk * 512 + h * 64 + d] << 16);
                        s = acc; }
                    sc[br][c] = s; mx = fmaxf(mx, s); } }
#pragma unroll
            for (int o = 1; o < 64; o <<= 1) mx = fmaxf(mx, __shfl_xor(mx, o));
            float lsum = 0.f;
#pragma unroll
            for (int br = 0; br < 3; ++br)
#pragma unroll
                for (int c = 0; c < 3; ++c) { sc[br][c] = __builtin_amdgcn_exp2f(sc[br][c] - mx); lsum += sc[br][c]; }
            lsum = wave_sum(lsum);
            float ov = 0.f;
#pragma unroll
            for (int br = 0; br < 3; ++br) { const int dil = (br == 0) ? 1 : (br == 1 ? 4 : 16);
#pragma unroll
                for (int c = 0; c < 3; ++c)
                    for (int l2 = 0; l2 < 64; ++l2) { const int j = l2 + 64 * c; const float p = __shfl(sc[br][c], l2);
                        if (j <= 128 && j <= ts / dil) { const int tk = b * SEQ + ts - j * dil; ov += p * __uint_as_float((unsigned)Vb[(size_t)tk * 512 + h * 64 + lane] << 16); } } }
            ov /= lsum;
            const float got = __uint_as_float((unsigned)MIX[(size_t)t * 1024 + 512 + h * 64 + lane] << 16);
            bool bad = !(fabsf(got - ov) <= 0.004f + 0.02f * fabsf(ov));
            { const int ch = h * 64 + lane, grp = ch >> 7, w = 2 << grp; const int cnt = (ts + 1 < w) ? ts + 1 : w; float sm = 0.f;
              for (int j = 0; j < cnt; ++j) sm += __uint_as_float((unsigned)Ub[(size_t)(t - j) * 512 + ch] << 16);
              const float pv = sm / (float)cnt - __uint_as_float((unsigned)Ub[(size_t)t * 512 + ch] << 16);
              const float gp = __uint_as_float((unsigned)MIX[(size_t)t * 1024 + ch] << 16);
              bad = bad || !(fabsf(gp - pv) <= 0.004f + 0.02f * fabsf(pv)); }
            if (__any(bad) && lane == 0) atomicAdd(CHK, 1u);
        }
    }
    xcd_barrier(bar);
#endif
    {
        pg8::Gemm g{MIX, WoT, D}; pg8::StaticOrder S; S.init(T, D, D * 2, G, bx);
        pg8::EpiResF32 E{x, XMID};
        pg8::gemm_phase<pg8::EpiResF32, pg8::StaticOrder, true>(lds, g, S, E);
    }
    xcd_barrier(bar);
#if (PROBE_DUP >> 4) & 1
    {
        pg8::Gemm g{MIX, WoT, D}; pg8::StaticOrder S; S.init(T, D, D * 2, G, bx);
        pg8::EpiResF32 E{x, XMID};
        pg8::gemm_phase<pg8::EpiResF32, pg8::StaticOrder, true>(lds, g, S, E);
    }
    xcd_barrier(bar);
#endif

    {
        {
            const u32x4* wri = (const u32x4*)(ws + WS_TAB);
#pragma unroll
            for (int p = 0; p < 16; ++p) *(LAS u32x4*)(lds + (tid + 512 * p) * 16) = wri[tid + 512 * p];
        }
        LAS float* lgf = (LAS float*)(lds + LDS_G_OFF);
        lgf[tid] = g_ffn[tid]; lgf[tid + 512] = g_ffn[tid + 512];
        __syncthreads();
        LAS int* ltopi = (LAS int*)(lds + LDS_TOPI_OFF);
        unsigned char* XG8 = ws + WS_XS; float* RSTD = (float*)(ws + WS_RSTD);
        const int i16 = lane & 15, fq = lane >> 4, ti = i16 & 7;
        if (bx == 0 && wave == 0) *(u32x4*)(XG8 + (size_t)T * 1024 + 16 * lane) = (u32x4){0u, 0u, 0u, 0u};
        float brv[8];
#pragma unroll
        for (int j = 0; j < 8; ++j) brv[j] = b_router[16 * (j >> 2) + 4 * fq + (j & 3)];
        for (int blk_ = vcu; blk_ < (T / 64); blk_ += G) {
            const int blk = blk_ & 255;
            {
                const int tl = 8 * wave + ti, t = 64 * blk + tl;
                const float* xr = XMID + (size_t)t * 1024 + 8 * fq;
                f32x4 acc0 = (f32x4){0.f, 0.f, 0.f, 0.f}, acc1 = (f32x4){0.f, 0.f, 0.f, 0.f}; float ssq = 0.f;
#pragma unroll 8
                for (int ks = 0; ks < 32; ++ks) {
                    const f32x4 xa = __builtin_nontemporal_load((const f32x4*)(xr + 32 * ks)), xb = __builtin_nontemporal_load((const f32x4*)(xr + 32 * ks + 4));
                    const f32x4 ga = *(const LAS f32x4*)(lgf + 32 * ks + 8 * fq), gb = *(const LAS f32x4*)(lgf + 32 * ks + 8 * fq + 4);
                    ssq += (xa.x * xa.x + xa.y * xa.y) + (xa.z * xa.z + xa.w * xa.w) + (xb.x * xb.x + xb.y * xb.y) + (xb.z * xb.z + xb.w * xb.w);
                    const f32x4 ya = xa * ga, yb = xb * gb;
                    u32x4 H; H.x = pkbf(ya.x, ya.y); H.y = pkbf(ya.z, ya.w); H.z = pkbf(yb.x, yb.y); H.w = pkbf(yb.z, yb.w);
                    u32x4 L; L.x = pkbf(ya.x - bflo(H.x), ya.y - bfhi(H.x)); L.y = pkbf(ya.z - bflo(H.y), ya.w - bfhi(H.y)); L.z = pkbf(yb.x - bflo(H.z), yb.y - bfhi(H.z)); L.w = pkbf(yb.z - bflo(H.w), yb.w - bfhi(H.w));
                    u32x2 f8; f8.x = pk4f8(ya.x * XS_SCALE, ya.y * XS_SCALE, ya.z * XS_SCALE, ya.w * XS_SCALE); f8.y = pk4f8(yb.x * XS_SCALE, yb.y * XS_SCALE, yb.z * XS_SCALE, yb.w * XS_SCALE);
                    if (i16 < 8) *(u32x2*)(XG8 + (size_t)t * 1024 + 32 * ks + 8 * fq) = f8;
                    const bf16x8 xh = __builtin_bit_cast(bf16x8, H), xl = __builtin_bit_cast(bf16x8, L);
                    const int ch = 4 * ks + fq;
                    const bf16x8 wh0 = *(const LAS bf16x8*)(lds + 2048 * i16 + 16 * (ch ^ i16)), wl0 = *(const LAS bf16x8*)(lds + 65536 + 2048 * i16 + 16 * (ch ^ i16));
                    const bf16x8 wh1 = *(const LAS bf16x8*)(lds + 2048 * (16 + i16) + 16 * (ch ^ i16)), wl1 = *(const LAS bf16x8*)(lds + 65536 + 2048 * (16 + i16) + 16 * (ch ^ i16));
                    acc0 = __builtin_amdgcn_mfma_f32_16x16x32_bf16(wh0, xh, acc0, 0, 0, 0); acc1 = __builtin_amdgcn_mfma_f32_16x16x32_bf16(wh1, xh, acc1, 0, 0, 0);
                    acc0 = __builtin_amdgcn_mfma_f32_16x16x32_bf16(wl0, xh, acc0, 0, 0, 0); acc1 = __builtin_amdgcn_mfma_f32_16x16x32_bf16(wl1, xh, acc1, 0, 0, 0);
                    acc0 = __builtin_amdgcn_mfma_f32_16x16x32_bf16(wh0, xl, acc0, 0, 0, 0); acc1 = __builtin_amdgcn_mfma_f32_16x16x32_bf16(wh1, xl, acc1, 0, 0, 0);
                }
                ssq += __shfl_xor(ssq, 16); ssq += __shfl_xor(ssq, 32);
                const float rstd = 1.0f / sqrtf(ssq * (1.f / D) + EPS);
                float my[8];
#pragma unroll
                for (int r = 0; r < 4; ++r) { my[r] = acc0[r] * rstd + brv[r]; my[4 + r] = acc1[r] * rstd + brv[4 + r]; }
                float lg[32];
#pragma unroll
                for (int f = 0; f < 4; ++f)
#pragma unroll
                    for (int j = 0; j < 8; ++j) lg[16 * (j >> 2) + 4 * f + (j & 3)] = __shfl(my[j], i16 + 16 * f);
                unsigned taken = 0u; float tv[4]; int tix[4];
#pragma unroll
                for (int r = 0; r < 4; ++r) { float best = -3.0e38f; int bi = 0;
#pragma unroll
                    for (int e = 0; e < 32; ++e) { const bool ok = !((taken >> e) & 1u) && (lg[e] > best); best = ok ? lg[e] : best; bi = ok ? e : bi; }
                    taken |= 1u << bi; tv[r] = best; tix[r] = bi; }
                const float e1 = __expf(tv[1] - tv[0]), e2 = __expf(tv[2] - tv[0]), e3 = __expf(tv[3] - tv[0]); const float is = 1.0f / (1.0f + e1 + e2 + e3);
                if (lane < 8) { *(int4*)(TOPI + (size_t)t * 4) = make_int4(tix[0], tix[1], tix[2], tix[3]); *(f32x4*)(GATE + (size_t)t * 4) = (f32x4){is, e1 * is, e2 * is, e3 * is};
                    RSTD[t] = rstd;
                    ltopi[tl * 4 + 0] = tix[0]; ltopi[tl * 4 + 1] = tix[1]; ltopi[tl * 4 + 2] = tix[2]; ltopi[tl * 4 + 3] = tix[3]; }
            }
            __syncthreads();
            if (wave == 0) {
                const int e0 = ltopi[lane * 4 + 0], e1 = ltopi[lane * 4 + 1], e2 = ltopi[lane * 4 + 2], e3 = ltopi[lane * 4 + 3];
                int r0 = 0, r1 = 0, r2 = 0, r3 = 0, mycnt = 0; const unsigned long long below = (1ull << lane) - 1ull;
                for (int e = 0; e < 32; ++e) { const bool hit = (e0 == e) | (e1 == e) | (e2 == e) | (e3 == e); const unsigned long long mk = __ballot(hit); const int rk = __popcll(mk & below);
                    if (e0 == e) r0 = rk; if (e1 == e) r1 = rk; if (e2 == e) r2 = rk; if (e3 == e) r3 = rk; if (lane == e) mycnt = __popcll(mk); }
                int base = 0; if (lane < 32) base = (int)__hip_atomic_fetch_add(CNT + lane, (unsigned)mycnt, __ATOMIC_RELAXED, __HIP_MEMORY_SCOPE_AGENT);
                r0 += __shfl(base, e0); r1 += __shfl(base, e1); r2 += __shfl(base, e2); r3 += __shfl(base, e3);
                const int tt = 64 * blk + lane;
                *(int4*)(LRANK + (size_t)tt * 4) = make_int4(r0, r1, r2, r3);
                INV[(size_t)e0 * T + r0] = tt; INV[(size_t)e1 * T + r1] = tt; INV[(size_t)e2 * T + r2] = tt; INV[(size_t)e3 * T + r3] = tt;
            }
            __syncthreads();
        }
    }
    xcd_barrier(bar);

    {
        LAS int* ltab = (LAS int*)(lds + LDS_TAB_OFF); LAS int* lnmt = (LAS int*)(lds + LDS_NMT_OFF);
        LAS int* lcnt = (LAS int*)(lds + LDS_P6_OFF), * lO = lcnt + 32;
        LAS int* lrow = (LAS int*)(lds + LDS_ROWT_OFF); LAS float* lrs = (LAS float*)(lds + LDS_RSTB_OFF);
        if (tid < 32) lcnt[tid] = (int)__hip_atomic_load(CNT + tid, __ATOMIC_RELAXED, __HIP_MEMORY_SCOPE_AGENT);
        __syncthreads();
        if (tid == 0) { int off = 0; for (int e = 0; e < 32; ++e) { lO[e] = off; off += ((lcnt[e] + 255) >> 8) << 8; } lO[32] = off; lnmt[0] = off >> 8; }
        __syncthreads();
        const int nmt = rfl(lnmt[0]);
        for (int mt = tid; mt < nmt && mt < 384; mt += NWAVES * 64) { int e = 0; for (int q = 1; q < 32; ++q) e += (lO[q] <= mt * 256) ? 1 : 0; ltab[mt] = e; }
        __syncthreads();
        {
            pg8::GroupedOrder S0; S0.init(nmt, 2048, D, G, bx, ltab, (size_t)2048 * 1024); pg8::Unit u0;
            const float* RSTD = (const float*)(ws + WS_RSTD);
            for (int i = 0; i < MAX_UNITS && S0.next(i, u0); ++i) if (tid < 256) {
                const int e = u0.e, rk = u0.pm * 256 - lO[e] + tid; const bool valid = rk < lcnt[e];
                const int tok = valid ? INV[(size_t)e * T + rk] : T;
                lrow[i * 256 + tid] = tok * 1024; lrs[i * 256 + tid] = valid ? RSTD[tok] : 0.f; }
        }
        __syncthreads();
        {
            pg8::Gemm8 g{XS, WguT, D}; pg8::GroupedOrder S; S.init(nmt, 2048, D, G, bx, ltab, (size_t)2048 * 1024);
            pg8::EpiSwiGLU E{ACT, b_gu, lrs};
            pg8::gemm_phase_f8<pg8::EpiSwiGLU, pg8::GroupedOrder, true, true>(lds, g, S, E, lrow);
        }
        xcd_barrier(bar);
        {
            pg8::Gemm8 g{ACT, WdT, DE}; pg8::GroupedOrder S; S.init(nmt, 1024, DE, G, bx, ltab, (size_t)1024 * 1024);
            pg8::EpiBiasBf16 E{Yb, b_down};
            pg8::gemm_phase_f8<pg8::EpiBiasBf16, pg8::GroupedOrder, true>(lds, g, S, E);
        }
    }
    xcd_barrier(bar);

    {
        unsigned bad = __hip_atomic_load((unsigned*)(ws + WS_CTL) + CW_BAR + XB_TMO, __ATOMIC_RELAXED, __HIP_MEMORY_SCOPE_AGENT);
#if (PROBE_DUP >> 14) & 1
        bad |= __hip_atomic_load((unsigned*)(ws + WS_CTL) + 2, __ATOMIC_RELAXED, __HIP_MEMORY_SCOPE_AGENT);
#endif
        LAS int* lO9 = (LAS int*)(lds + LDS_P6_OFF) + 32;
        __syncthreads();
        if (tid == 0) { int off = 0; for (int e = 0; e < 32; ++e) { lO9[e] = off; off += (((int)__hip_atomic_load(CNT + e, __ATOMIC_RELAXED, __HIP_MEMORY_SCOPE_AGENT) + 255) >> 8) << 8; } }
        __syncthreads();
        for (int t_ = gw; t_ < DUPN(9) * T; t_ += NGW) {
            const int t = t_ & (T - 1);
            const int4 ee = *(const int4*)(TOPI + (size_t)t * 4), rk = *(const int4*)(LRANK + (size_t)t * 4);
            const int4 ps = make_int4(lO9[ee.x] + rk.x, lO9[ee.y] + rk.y, lO9[ee.z] + rk.z, lO9[ee.w] + rk.w); const f32x4 gt = *(const f32x4*)(GATE + (size_t)t * 4);
            const f32x4* xr = (const f32x4*)(XMID + (size_t)t * 1024) + lane; const f32x4* gr = (const f32x4*)g_final + lane;
            const unsigned* y0 = (const unsigned*)(Yb + (size_t)ps.x * 1024) + lane; const unsigned* y1 = (const unsigned*)(Yb + (size_t)ps.y * 1024) + lane;
            const unsigned* y2 = (const unsigned*)(Yb + (size_t)ps.z * 1024) + lane; const unsigned* y3 = (const unsigned*)(Yb + (size_t)ps.w * 1024) + lane;
            const f32x4 gs = gt * (1.0f / Y_SCALE);
            f32x4 v[4]; float s = 0.f;
#pragma unroll
            for (int j = 0; j < 4; ++j) { v[j] = __builtin_nontemporal_load(xr + 64 * j); const int a = (int)__builtin_nontemporal_load(y0 + 64 * j), b = (int)__builtin_nontemporal_load(y1 + 64 * j), c = (int)__builtin_nontemporal_load(y2 + 64 * j), d = (int)__builtin_nontemporal_load(y3 + 64 * j);
                const f32x2 al = __builtin_amdgcn_cvt_pk_f32_fp8(a, false), ah = __builtin_amdgcn_cvt_pk_f32_fp8(a, true), bl = __builtin_amdgcn_cvt_pk_f32_fp8(b, false), bh = __builtin_amdgcn_cvt_pk_f32_fp8(b, true);
                const f32x2 cl = __builtin_amdgcn_cvt_pk_f32_fp8(c, false), chh = __builtin_amdgcn_cvt_pk_f32_fp8(c, true), dl = __builtin_amdgcn_cvt_pk_f32_fp8(d, false), dh = __builtin_amdgcn_cvt_pk_f32_fp8(d, true);
                v[j].x += gs.x * al.x + gs.y * bl.x + gs.z * cl.x + gs.w * dl.x;
                v[j].y += gs.x * al.y + gs.y * bl.y + gs.z * cl.y + gs.w * dl.y;
                v[j].z += gs.x * ah.x + gs.y * bh.x + gs.z * chh.x + gs.w * dh.x;
                v[j].w += gs.x * ah.y + gs.y * bh.y + gs.z * chh.y + gs.w * dh.y;
                s += (v[j].x * v[j].x + v[j].y * v[j].y) + (v[j].z * v[j].z + v[j].w * v[j].w); }
            float rstd = 1.0f / sqrtf(wave_sum(s) * (1.f / D) + EPS);
            if (bad) rstd = __builtin_nanf("");
            f32x4* orow = (f32x4*)(out + (size_t)t * 1024) + lane;
#pragma unroll
            for (int j = 0; j < 4; ++j) { const f32x4 gv = gr[64 * j]; __builtin_nontemporal_store(v[j] * rstd * gv, orow + 64 * j); }
        }
    }
}

extern "C" void kernel_launch(void* const* d_in, const int* in_sizes, int n_in, void* d_out, int out_size, void* d_ws, size_t ws_size, hipStream_t stream) {
    static int grid = 0;
    if (grid == 0) {
        if (n_in != 14 || in_sizes[0] != T * D || out_size != T * D || ws_size < WS_END) { fprintf(stderr, "kernel_launch: unexpected shapes (n_in %d, in0 %d, out %d, ws %zu)\n", n_in, n_in > 0 ? in_sizes[0] : -1, out_size, ws_size); grid = -1; return; }
        int dev = 0, cus = 0, per_cu = 0;
        if (hipGetDevice(&dev) != hipSuccess || hipDeviceGetAttribute(&cus, hipDeviceAttributeMultiprocessorCount, dev) != hipSuccess) { grid = -1; return; }
        if (hipFuncSetAttribute((const void*)mega_fwd, hipFuncAttributeMaxDynamicSharedMemorySize, LDS_BYTES) != hipSuccess) { fprintf(stderr, "kernel_launch: hipFuncSetAttribute failed\n"); grid = -1; return; }
        if (hipOccupancyMaxActiveBlocksPerMultiprocessor(&per_cu, (const void*)mega_fwd, NWAVES * 64, LDS_BYTES) != hipSuccess || per_cu < 1)
            fprintf(stderr, "kernel_launch: note: occupancy query reports %d workgroups per CU\n", per_cu);
        (void)hipGetLastError();
        grid = cus;
    }
    if (grid < 0) return;
    if (hipMemsetAsync((char*)d_ws + WS_CTL, 0, CTL_ZERO_BYTES, stream) != hipSuccess) return;
    Args a{};
    for (int i = 0; i < 14; ++i) a.in[i] = (const float*)d_in[i];
    a.out = (float*)d_out; a.ws = (unsigned char*)d_ws;
    hipLaunchKernelGGL(mega_fwd, dim3(grid), dim3(NWAVES * 64), LDS_BYTES, stream, a);
}
```
